# Optimizing an MI355X kernel written in HIP

```python
import jax, jax.numpy as jnp
from jax import lax
import numpy as np

D_MODEL = 2048
BATCH = 4
SEQ = 2048
DEPTH = 2

PLE_DIM = 256
LRU_WIDTH = 1024
LRU_BLOCKS = 8
LRU_BLOCK_W = LRU_WIDTH // LRU_BLOCKS
LRU_C = 8.0
CONV_WIDTH = 4
ATT_HEADS = 8
ATT_HEAD_DIM = 128
IDX_HEADS = 16
IDX_HEAD_DIM = 64
TOPK_MAX = 256
SPARSE_Q_BLOCK = 64
MLA_HEADS = 8
MLA_Q_LORA = 768
MLA_KV_LORA = 512
MLA_NOPE = 128
MLA_ROPE = 64
MLA_QK = MLA_NOPE + MLA_ROPE
MLA_V = 128
DENSE_Q_BLOCK = 128
N_BRANCH = 3
BRANCH_WIDTH = 1024
D_FF = 5632
N_EXPERTS = 8
TOP_K = 2
D_FF_EXPERT = 7168
MOE_ROW_BLOCK = 256
ROPE_THETA = 10000.0
EPS = 1e-6
N_DENSE = (DEPTH + 1) // 2
N_MOE = DEPTH // 2
IN_SPLITS = (LRU_WIDTH, LRU_WIDTH,
             ATT_HEADS * ATT_HEAD_DIM, ATT_HEADS * ATT_HEAD_DIM, ATT_HEADS * ATT_HEAD_DIM,
             IDX_HEADS * IDX_HEAD_DIM, IDX_HEAD_DIM, IDX_HEADS,
             MLA_Q_LORA, MLA_KV_LORA, MLA_ROPE,
             N_BRANCH * D_MODEL)
D_IN = sum(IN_SPLITS)

kernel_name = 'hybrid_rglru_dsa_mla_moe_block'


def rms_norm(x, g):
    x32 = x.astype(jnp.float32)
    y = x32 * lax.rsqrt(jnp.mean(x32 * x32, axis=-1, keepdims=True) + EPS)
    return (y * g.astype(jnp.float32)).astype(x.dtype)


def rope(x, positions):
    d = x.shape[-1]
    inv_freq = ROPE_THETA ** (-jnp.arange(0, d, 2, dtype=jnp.float32) / d)
    ang = positions.astype(jnp.float32)[:, :, None, None] * inv_freq
    cos, sin = jnp.cos(ang), jnp.sin(ang)
    x32 = x.astype(jnp.float32)
    x1, x2 = x32[..., :d // 2], x32[..., d // 2:]
    return jnp.concatenate([x1 * cos - x2 * sin, x2 * cos + x1 * sin], axis=-1).astype(x.dtype)


def rglru_branch(xb, gb, conv_w, conv_b, wa, ba, wx, bx, lam):
    B_, T_, C = xb.shape
    xc = lax.conv_general_dilated(xb, conv_w[:, None, :].astype(xb.dtype), window_strides=(1,),
                                  padding=[(CONV_WIDTH - 1, 0)],
                                  dimension_numbers=('NWC', 'WIO', 'NWC'),
                                  feature_group_count=C) + conv_b
    xblk = xc.reshape(B_, T_, LRU_BLOCKS, LRU_BLOCK_W)
    r = jax.nn.sigmoid(jnp.einsum('btnc,ncd->btnd', xblk, wa).reshape(B_, T_, C) + ba)
    i = jax.nn.sigmoid(jnp.einsum('btnc,ncd->btnd', xblk, wx).reshape(B_, T_, C) + bx)
    log_a = -LRU_C * r.astype(jnp.float32) * jax.nn.softplus(-lam.astype(jnp.float32))
    a = jnp.exp(log_a)
    b = jnp.sqrt(-jnp.expm1(2.0 * log_a)) * (i * xc).astype(jnp.float32)

    def combine(left, right):
        a1, b1 = left
        a2, b2 = right
        return a1 * a2, a2 * b1 + b2

    _, h = lax.associative_scan(combine, (a, b), axis=1)
    return h.astype(xb.dtype) * jax.nn.gelu(gb, approximate=True)


def sparse_index_attention(q, k, v, q_idx, k_idx, w_idx, n_sel):
    B_, T_, H, d = q.shape
    nb = T_ // SPARSE_Q_BLOCK
    key_pos = jnp.arange(T_)
    idx_scale = IDX_HEADS ** -0.5 * IDX_HEAD_DIM ** -0.5

    def blockify(t):
        return t.reshape((B_, nb, SPARSE_Q_BLOCK) + t.shape[2:]).swapaxes(0, 1)

    def one_block(args):
        qb, qib, wb, q0 = args
        qpos = q0 + jnp.arange(SPARSE_Q_BLOCK)
        s = jax.nn.relu(jnp.einsum('bqhc,bkc->bqkh', qib, k_idx).astype(jnp.float32))
        score = jnp.einsum('bqkh,bqh->bqk', s, wb.astype(jnp.float32)) * idx_scale
        causal = key_pos[None, :] <= qpos[:, None]
        score = jnp.where(causal[None], score, -jnp.inf)
        _, sel = lax.top_k(score, n_sel)
        k_sel = jax.vmap(lambda kb, ib: kb[ib])(k, sel)
        v_sel = jax.vmap(lambda vb, ib: vb[ib])(v, sel)
        logits = jnp.einsum('bqhd,bqnhd->bhqn', qb, k_sel).astype(jnp.float32) * d ** -0.5
        valid = sel <= qpos[None, :, None]
        logits = jnp.where(valid[:, None], logits, -jnp.inf)
        prob = jax.nn.softmax(logits, axis=-1).astype(v.dtype)
        return jnp.einsum('bhqn,bqnhd->bqhd', prob, v_sel)

    starts = jnp.arange(nb) * SPARSE_Q_BLOCK
    out = lax.map(one_block, (blockify(q), blockify(q_idx), blockify(w_idx), starts))
    return out.swapaxes(0, 1).reshape(B_, T_, H * d)


def causal_block_attention(q, k, v):
    B_, T_, H, dq = q.shape
    nb = T_ // DENSE_Q_BLOCK
    key_pos = jnp.arange(T_)
    qblocks = q.reshape(B_, nb, DENSE_Q_BLOCK, H, dq).swapaxes(0, 1)

    def one_block(args):
        qb, q0 = args
        qpos = q0 + jnp.arange(DENSE_Q_BLOCK)
        logits = jnp.einsum('bqhd,bkhd->bhqk', qb, k).astype(jnp.float32) * dq ** -0.5
        logits = jnp.where(key_pos[None, :] <= qpos[:, None], logits, -jnp.inf)
        prob = jax.nn.softmax(logits, axis=-1).astype(v.dtype)
        return jnp.einsum('bhqk,bkhd->bqhd', prob, v)

    out = lax.map(one_block, (qblocks, jnp.arange(nb) * DENSE_Q_BLOCK))
    return out.swapaxes(0, 1).reshape(B_, T_, H * v.shape[-1])


def mla_branch(c_q, c_kv, k_rope, positions, qa_norm, kva_norm, w_uq, w_ukv, qn, kn):
    B_, T_, _ = c_q.shape
    q = (rms_norm(c_q, qa_norm) @ w_uq).reshape(B_, T_, MLA_HEADS, MLA_QK)
    kv = (rms_norm(c_kv, kva_norm) @ w_ukv).reshape(B_, T_, MLA_HEADS, MLA_NOPE + MLA_V)
    k_nope, v = kv[..., :MLA_NOPE], kv[..., MLA_NOPE:]
    k_r = jnp.broadcast_to(k_rope[:, :, None, :], (B_, T_, MLA_HEADS, MLA_ROPE))
    k = jnp.concatenate([k_nope, k_r], axis=-1)
    q = rms_norm(q, qn)
    k = rms_norm(k, kn)
    q = jnp.concatenate([q[..., :MLA_NOPE], rope(q[..., MLA_NOPE:], positions)], axis=-1)
    k = jnp.concatenate([k[..., :MLA_NOPE], rope(k[..., MLA_NOPE:], positions)], axis=-1)
    return causal_block_attention(q, k, v)


def dense_swiglu(h2, wg, wu, wd):
    return (jax.nn.silu(h2 @ wg) * (h2 @ wu)) @ wd


def moe_swiglu(h2, router, w_gate, w_up, w_down):
    T_, D_ = h2.shape
    logits = (h2 @ router).astype(jnp.float32)
    top_val, top_idx = lax.top_k(logits, TOP_K)
    gate = jax.nn.softmax(top_val, axis=-1)
    n_assign = T_ * TOP_K
    e_flat = top_idx.reshape(n_assign)
    tok_flat = jnp.repeat(jnp.arange(T_, dtype=jnp.int32), TOP_K)
    g_flat = gate.reshape(n_assign)
    order = jnp.argsort(e_flat)
    e_s, tok_s, g_s = e_flat[order], tok_flat[order], g_flat[order]
    counts = jnp.bincount(e_flat, length=N_EXPERTS)
    padded = (counts + MOE_ROW_BLOCK - 1) // MOE_ROW_BLOCK * MOE_ROW_BLOCK
    pad_ends = jnp.cumsum(padded)
    pad_starts = pad_ends - padded
    starts = jnp.cumsum(counts) - counts
    dest = pad_starts[e_s] + (jnp.arange(n_assign) - starts[e_s])
    n_blocks = -(-n_assign // MOE_ROW_BLOCK) + N_EXPERTS
    n_rows = n_blocks * MOE_ROW_BLOCK
    row_tok = jnp.full((n_rows,), T_, jnp.int32).at[dest].set(tok_s)
    row_gate = jnp.zeros((n_rows,), jnp.float32).at[dest].set(g_s)
    blk_expert = jnp.minimum(
        jnp.searchsorted(pad_ends, jnp.arange(n_blocks) * MOE_ROW_BLOCK, side='right'),
        N_EXPERTS - 1)
    h_pad = jnp.concatenate([h2, jnp.zeros((1, D_), h2.dtype)], axis=0)
    xs = h_pad[row_tok].reshape(n_blocks, MOE_ROW_BLOCK, D_)

    def expert_block(args):
        xb, e = args
        return (jax.nn.silu(xb @ w_gate[e]) * (xb @ w_up[e])) @ w_down[e]

    ys = lax.map(expert_block, (xs, blk_expert)).reshape(n_rows, D_)
    ys = ys * row_gate[:, None].astype(ys.dtype)
    return jnp.zeros((T_ + 1, D_), ys.dtype).at[row_tok].add(ys)[:T_]


def setup_inputs(seed: int = 0) -> dict:
    key = jax.random.key(seed)
    ks = jax.random.split(key, 40)
    f32 = jnp.float32

    def nrm(k, shape, scale):
        return jax.random.normal(k, shape, f32) * scale

    def gain(k, shape):
        return 1.0 + 0.02 * jax.random.normal(k, shape, f32)

    u = jax.random.uniform(ks[11], (DEPTH, LRU_WIDTH), f32)
    a_c = 0.81 + 0.188 * u
    a = a_c ** (1.0 / LRU_C)
    lru_lambda = jnp.log(a) - jnp.log1p(-a)
    return {
        'x': nrm(ks[0], (BATCH, SEQ, D_MODEL), 1.0),
        'p': nrm(ks[1], (DEPTH, BATCH, SEQ, PLE_DIM), 1.0),
        'positions': jnp.broadcast_to(jnp.arange(SEQ, dtype=jnp.int32)[None, :], (BATCH, SEQ)),
        'ln_mix': gain(ks[2], (DEPTH, D_MODEL)),
        'w_in': nrm(ks[3], (DEPTH, D_MODEL, D_IN), D_MODEL ** -0.5),
        'conv_w': nrm(ks[4], (DEPTH, CONV_WIDTH, LRU_WIDTH), 0.5),
        'conv_b': nrm(ks[5], (DEPTH, LRU_WIDTH), 0.01),
        'lru_wa': nrm(ks[6], (DEPTH, LRU_BLOCKS, LRU_BLOCK_W, LRU_BLOCK_W), LRU_BLOCK_W ** -0.5),
        'lru_ba': nrm(ks[7], (DEPTH, LRU_WIDTH), 0.01),
        'lru_wx': nrm(ks[8], (DEPTH, LRU_BLOCKS, LRU_BLOCK_W, LRU_BLOCK_W), LRU_BLOCK_W ** -0.5),
        'lru_bx': nrm(ks[9], (DEPTH, LRU_WIDTH), 0.01),
        'lru_lambda': lru_lambda,
        'att_q_norm': gain(ks[12], (DEPTH, ATT_HEAD_DIM)),
        'att_k_norm': gain(ks[13], (DEPTH, ATT_HEAD_DIM)),
        'mla_qa_norm': gain(ks[14], (DEPTH, MLA_Q_LORA)),
        'mla_kva_norm': gain(ks[15], (DEPTH, MLA_KV_LORA)),
        'mla_w_uq': nrm(ks[16], (DEPTH, MLA_Q_LORA, MLA_HEADS * MLA_QK), MLA_Q_LORA ** -0.5),
        'mla_w_ukv': nrm(ks[17], (DEPTH, MLA_KV_LORA, MLA_HEADS * (MLA_NOPE + MLA_V)), MLA_KV_LORA ** -0.5),
        'mla_q_norm': gain(ks[18], (DEPTH, MLA_QK)),
        'mla_k_norm': gain(ks[19], (DEPTH, MLA_QK)),
        'w_branch': nrm(ks[20], (DEPTH, N_BRANCH, BRANCH_WIDTH, D_MODEL), BRANCH_WIDTH ** -0.5),
        'w_out': nrm(ks[21], (DEPTH, D_MODEL, D_MODEL), D_MODEL ** -0.5),
        'ln_ffn': gain(ks[22], (DEPTH, D_MODEL)),
        'dense_w_gate': nrm(ks[23], (N_DENSE, D_MODEL, D_FF), D_MODEL ** -0.5),
        'dense_w_up': nrm(ks[24], (N_DENSE, D_MODEL, D_FF), D_MODEL ** -0.5),
        'dense_w_down': nrm(ks[25], (N_DENSE, D_FF, D_MODEL), D_FF ** -0.5),
        'moe_router': nrm(ks[26], (N_MOE, D_MODEL, N_EXPERTS), D_MODEL ** -0.5),
        'moe_w_gate': nrm(ks[27], (N_MOE, N_EXPERTS, D_MODEL, D_FF_EXPERT), D_MODEL ** -0.5),
        'moe_w_up': nrm(ks[28], (N_MOE, N_EXPERTS, D_MODEL, D_FF_EXPERT), D_MODEL ** -0.5),
        'moe_w_down': nrm(ks[29], (N_MOE, N_EXPERTS, D_FF_EXPERT, D_MODEL), D_FF_EXPERT ** -0.5),
        'ple_norm': gain(ks[30], (DEPTH, D_MODEL)),
        'ple_w_gate': nrm(ks[31], (DEPTH, D_MODEL, D_MODEL), D_MODEL ** -0.5),
        'ple_w_proj': nrm(ks[32], (DEPTH, PLE_DIM, D_MODEL), PLE_DIM ** -0.5),
    }


def reference(x, p, positions, ln_mix, w_in, conv_w, conv_b, lru_wa, lru_ba, lru_wx, lru_bx,
              lru_lambda, att_q_norm, att_k_norm, mla_qa_norm, mla_kva_norm, mla_w_uq, mla_w_ukv,
              mla_q_norm, mla_k_norm, w_branch, w_out, ln_ffn, dense_w_gate, dense_w_up,
              dense_w_down, moe_router, moe_w_gate, moe_w_up, moe_w_down, ple_norm, ple_w_gate,
              ple_w_proj):
    B_, T_, D_ = x.shape
    n_sel = min(TOPK_MAX, T_ // 4)
    split_at = np.cumsum(IN_SPLITS)[:-1].tolist()
    h = x
    for i in range(DEPTH):
        hn = rms_norm(h, ln_mix[i])
        proj = hn @ w_in[i]
        (lru_x, lru_g, aq, ak, av, iq, ik, iw, cq, ckv, kr, gate_logits) = jnp.split(proj, split_at, axis=-1)

        out_a = rglru_branch(lru_x, lru_g, conv_w[i], conv_b[i], lru_wa[i], lru_ba[i],
                             lru_wx[i], lru_bx[i], lru_lambda[i])

        q = rope(rms_norm(aq.reshape(B_, T_, ATT_HEADS, ATT_HEAD_DIM), att_q_norm[i]), positions)
        k = rope(rms_norm(ak.reshape(B_, T_, ATT_HEADS, ATT_HEAD_DIM), att_k_norm[i]), positions)
        v = av.reshape(B_, T_, ATT_HEADS, ATT_HEAD_DIM)
        q_idx = rope(iq.reshape(B_, T_, IDX_HEADS, IDX_HEAD_DIM), positions)
        k_idx = rope(ik[:, :, None, :], positions)[:, :, 0, :]
        out_b = sparse_index_attention(q, k, v, q_idx, k_idx, iw, n_sel)

        out_c = mla_branch(cq, ckv, kr, positions, mla_qa_norm[i], mla_kva_norm[i],
                           mla_w_uq[i], mla_w_ukv[i], mla_q_norm[i], mla_k_norm[i])

        branches = jnp.stack([out_a, out_b, out_c], axis=2)
        br_proj = jnp.einsum('btnc,ncd->btnd', branches, w_branch[i])
        gates = jax.nn.sigmoid(gate_logits.reshape(B_, T_, N_BRANCH, D_))
        merged = jnp.einsum('btnd,btnd->btd', gates, br_proj)
        h = h + merged @ w_out[i]

        hn2 = rms_norm(h, ln_ffn[i])
        if i % 2 == 0:
            j = i // 2
            ff = dense_swiglu(hn2, dense_w_gate[j], dense_w_up[j], dense_w_down[j])
        else:
            j = i // 2
            ff = moe_swiglu(hn2.reshape(B_ * T_, D_), moe_router[j], moe_w_gate[j],
                            moe_w_up[j], moe_w_down[j]).reshape(B_, T_, D_)
        h = h + ff

        ple_gate = jax.nn.sigmoid(rms_norm(h, ple_norm[i]) @ ple_w_gate[i])
        h = h + (p[i] @ ple_w_proj[i]) * ple_gate
    return h
```

```cpp
#include <hip/hip_runtime.h>
#include <cstdio>
#include <cstdint>

#ifndef FAST_GEMM
#define FAST_GEMM 1
#endif
#ifndef FAST_CONV
#define FAST_CONV 1
#endif
#ifndef FAST_ATTN_S
#define FAST_ATTN_S 1
#endif
#ifndef FAST_ATTN_M
#define FAST_ATTN_M 1
#endif
#ifndef FAST_IDX
#define FAST_IDX 1
#endif
#ifndef PROBE_ID
#define PROBE_ID -1
#endif
#define PB(id) ((PROBE_ID == (id)) ? 2 : 1)
#ifndef FP8_MOE
#define FP8_MOE 1
#endif
#ifndef FP8_DENSE
#define FP8_DENSE 0
#endif
#ifndef FP8_GATES
#define FP8_GATES 1
#endif
#ifndef BG_NOWAITWORK
#define BG_NOWAITWORK 0
#endif
#ifndef BG_CONV
#define BG_CONV 1
#endif
#ifndef N_LAUNCH_MODE
#define N_LAUNCH_MODE 1
#endif

#define LAS __attribute__((address_space(3)))
typedef unsigned short bf16;
typedef short bf16x8 __attribute__((ext_vector_type(8)));
typedef float f32x4 __attribute__((ext_vector_type(4)));
typedef unsigned u32x4 __attribute__((ext_vector_type(4)));
typedef unsigned u32x2 __attribute__((ext_vector_type(2)));
typedef unsigned long long u64;

constexpr int NB = 4, T = 2048, M = NB * T, D = 2048;
constexpr int PROJ_N = 13824;
constexpr int PX_LRUX = 0, PX_LRUG = 1024, PX_AQ = 2048, PX_AK = 3072, PX_AV = 4096, PX_IQ = 5120, PX_CQ = 6144, PX_CKV = 6912, PX_IK = 7424, PX_KR = 7488, PX_IW = 7552, PX_GATE = 7680;
constexpr int DFF = 5632, EFF = 7168, NEXP = 8, MOE_ROWS = 18432, MOE_BLKS = 72;
constexpr float EPS = 1e-6f;
constexpr float LOG2_THETA = 13.287712379549449f;
constexpr float INV_2PI = 0.15915494309189535f;

constexpr size_t CTL_BYTES = 1u << 20;
constexpr size_t SZ_WIN = (size_t)PROJ_N * 2048 * 2, SZ_WLRU = (size_t)2048 * 256 * 2, SZ_WUQ = (size_t)1536 * 768 * 2, SZ_WUKV = (size_t)2048 * 512 * 2,
                 SZ_WBR = (size_t)2048 * 1024 * 2, SZ_WOUT = (size_t)2048 * 2048 * 2, SZ_WD1 = (size_t)2 * DFF * 2048 * 2, SZ_WD2 = (size_t)2048 * DFF * 2,
                 SZ_WM1 = (size_t)2 * EFF * 2048 * 2, SZ_WM2 = (size_t)2048 * EFF * 2, SZ_WPG = (size_t)2048 * 2048 * 2, SZ_WPP = (size_t)2048 * 256 * 2, SZ_PBF = (size_t)M * 256 * 2;
constexpr size_t O_WIN = CTL_BYTES;
constexpr size_t O_WLRU = O_WIN + 2 * SZ_WIN;
constexpr size_t O_WUQ = O_WLRU + 2 * SZ_WLRU;
constexpr size_t O_WUKV = O_WUQ + 2 * SZ_WUQ;
constexpr size_t O_WBR = O_WUKV + 2 * SZ_WUKV;
constexpr size_t O_WOUT = O_WBR + 6 * SZ_WBR;
constexpr size_t O_WD1 = O_WOUT + 2 * SZ_WOUT;
constexpr size_t O_WD2 = O_WD1 + SZ_WD1;
constexpr size_t O_WM1 = O_WD2 + SZ_WD2;
constexpr size_t O_WM2 = O_WM1 + 8 * SZ_WM1;
constexpr size_t O_WPG = O_WM2 + 8 * SZ_WM2;
constexpr size_t O_WPP = O_WPG + 2 * SZ_WPG;
constexpr size_t O_PBF = O_WPP + 2 * SZ_WPP;
constexpr size_t O_H = O_PBF + 2 * SZ_PBF;
constexpr size_t O_HN = O_H + (size_t)M * D * 4;
constexpr size_t O_PP = O_HN + (size_t)M * D * 2;
constexpr size_t O_MOEI = O_PP + (size_t)M * D * 2;
constexpr size_t O_HN8 = O_MOEI + (1u << 20);
constexpr size_t O_SCR = O_HN8 + (size_t)M * D;
constexpr size_t O_PROJ = O_SCR;
constexpr size_t O_XC = O_PROJ + (size_t)M * PROJ_N * 2;
constexpr size_t O_LA = O_XC + (size_t)M * 1024 * 2;
constexpr size_t O_LB = O_LA + (size_t)M * 1024 * 4;
constexpr size_t O_BR = O_LB + (size_t)M * 1024 * 4;
constexpr size_t O_QS = O_BR + (size_t)3 * M * 1024 * 2;
constexpr size_t O_KS = O_QS + (size_t)M * 1024 * 2;
constexpr size_t O_VTS = O_KS + (size_t)M * 1024 * 2;
constexpr size_t O_QI = O_VTS + (size_t)M * 1024 * 2;
constexpr size_t O_KI = O_QI + (size_t)M * 1024 * 2;
constexpr size_t O_SEL = O_KI + (size_t)M * 64 * 2;
constexpr size_t O_CQN = O_SEL + (size_t)M * 32 * 8;
constexpr size_t O_CKVN = O_CQN + (size_t)M * 768 * 2;
constexpr size_t O_QMR = O_CKVN + (size_t)M * 512 * 2;
constexpr size_t O_KVMR = O_QMR + (size_t)M * 1536 * 2;
constexpr size_t O_QM = O_KVMR + (size_t)M * 2048 * 2;
constexpr size_t O_KM = O_QM + (size_t)M * 1536 * 2;
constexpr size_t O_VTM = O_KM + (size_t)M * 1536 * 2;
constexpr size_t O_MF = O_VTM + (size_t)M * 1024 * 2;
constexpr size_t O_MG = O_MF + (size_t)M * D * 4;
constexpr size_t O_MIXEND = O_MG + (size_t)M * D * 2;
constexpr size_t O_HMID = O_SCR;
constexpr size_t O_XS = O_HMID + (size_t)MOE_ROWS * EFF * 2;
constexpr size_t O_YS = O_XS + (size_t)MOE_ROWS * D * 2;
constexpr size_t O_FFNEND = O_YS + (size_t)2 * MOE_ROWS * D * 4;
constexpr size_t WS_END = O_MIXEND > O_FFNEND ? O_MIXEND : O_FFNEND;
static_assert(WS_END <= 1998027776ull, "workspace map exceeds the guaranteed d_ws size");
static_assert((O_H % 256) == 0 && (O_SCR % 256) == 0 && (O_XC % 256) == 0, "alignment");
constexpr int MI_TOKE = 0;
constexpr int MI_TOKG = MI_TOKE + 2 * M;
constexpr int MI_DEST = MI_TOKG + 2 * M;
constexpr int MI_ROWTOK = MI_DEST + 2 * M;
constexpr int MI_ROWG = MI_ROWTOK + MOE_ROWS;
constexpr int MI_BLKE = MI_ROWG + MOE_ROWS;
constexpr int MI_NUSED = MI_BLKE + 128;
constexpr int MI_BSTART = MI_NUSED + 16;
constexpr int MI_SP8 = MI_BSTART + 64;
static_assert((MI_SP8 + 2048) * 4 <= (1 << 20), "moe tables");

#define XB_TMO      128
#define XB_XCNT(j)  (256  + 64 * (j))
#define XB_XSUB(j)  (1280 + 64 * (j))
#define XB_XGEN(j)  (2304 + 64 * (j))
#define XB_TOP      3328
#define XB_TOPGEN   3392
#define XCD_BAR_WORDS 3456
#define XB_SPIN_CAP (1u << 18)
constexpr int CW_BAR = 4096;

constexpr int LDS_RING = 131072, LDS_MISC = LDS_RING + 256, LDS_BYTES = 147456;

__device__ __forceinline__ unsigned pk2(float lo, float hi) { unsigned r; asm("v_cvt_pk_bf16_f32 %0, %1, %2" : "=v"(r) : "v"(lo), "v"(hi)); return r; }
__device__ __forceinline__ bf16 f2bf(float f) { return (bf16)(pk2(f, 0.f) & 0xffffu); }
__device__ __forceinline__ float bf2f(bf16 b) { return __builtin_bit_cast(float, (unsigned)b << 16); }
__device__ __forceinline__ float bflo(unsigned w) { return __builtin_bit_cast(float, w << 16); }
__device__ __forceinline__ float bfhi(unsigned w) { return __builtin_bit_cast(float, w & 0xffff0000u); }
__device__ __forceinline__ unsigned pk4_fp8(float a, float b, float c, float d) { int p = 0; p = __builtin_amdgcn_cvt_pk_fp8_f32(a, b, p, false); p = __builtin_amdgcn_cvt_pk_fp8_f32(c, d, p, true); return (unsigned)p; }
constexpr float F8_WSCALE = 512.f, F8_XSCALE = 16.f, F8_HSCALE = 8.f;
__device__ __forceinline__ float wave_sum(float v) {
#pragma unroll
    for (int o = 1; o < 64; o <<= 1) v += __shfl_xor(v, o);
    return v;
}
__device__ __forceinline__ int wave_sum_i(int v) {
    v += __builtin_amdgcn_update_dpp(0, v, 0x111, 0xf, 0xf, true);
    v += __builtin_amdgcn_update_dpp(0, v, 0x112, 0xf, 0xf, true);
    v += __builtin_amdgcn_update_dpp(0, v, 0x114, 0xf, 0xf, true);
    v += __builtin_amdgcn_update_dpp(0, v, 0x118, 0xf, 0xf, true);
    return __builtin_amdgcn_readlane(v, 15) + __builtin_amdgcn_readlane(v, 31) + __builtin_amdgcn_readlane(v, 47) + __builtin_amdgcn_readlane(v, 63);
}
__device__ __forceinline__ float wave_max(float v) {
#pragma unroll
    for (int o = 1; o < 64; o <<= 1) v = fmaxf(v, __shfl_xor(v, o));
    return v;
}
__device__ __forceinline__ float relu_(float x) { return __builtin_amdgcn_fmed3f(x, 0.f, __builtin_inff()); }
__device__ __forceinline__ float sigmoidf_(float x) { return __builtin_amdgcn_rcpf(1.0f + __expf(-x)); }
__device__ __forceinline__ float gelu_tanh(float x) { const float z = 0.7978845608028654f * (x + 0.044715f * x * x * x); const float e = __expf(2.0f * z); return x * (1.0f - __builtin_amdgcn_rcpf(1.0f + e)); }
__device__ __forceinline__ float rd_lane(float v, int l) { return __builtin_bit_cast(float, __builtin_amdgcn_readlane(__builtin_bit_cast(int, v), l)); }
__device__ __forceinline__ unsigned rd_lane_u(unsigned v, int l) { return (unsigned)__builtin_amdgcn_readlane((int)v, l); }

__device__ __forceinline__ unsigned xb_ld(unsigned* p)              { return __hip_atomic_load(p, __ATOMIC_RELAXED, __HIP_MEMORY_SCOPE_AGENT); }
__device__ __forceinline__ unsigned xb_add(unsigned* p, unsigned v) { return __hip_atomic_fetch_add(p, v, __ATOMIC_RELAXED, __HIP_MEMORY_SCOPE_AGENT); }
__device__ __forceinline__ unsigned xb_xcc_id() { return (unsigned)__builtin_amdgcn_s_getreg((3 << 11) | 20) & 0xFu; }
#define XB_SPIN(cond, bar) do { unsigned _sp = 0; while (cond) { __builtin_amdgcn_s_sleep(1); \
    if ((++_sp & 255u) == 0u) { if (xb_ld(&(bar)[XB_TMO])) break; if (_sp > XB_SPIN_CAP) { atomicAdd(&(bar)[XB_TMO], 1u); break; } } } } while (0)
struct XcdBarrier { unsigned* bar; unsigned x; volatile LAS unsigned* st; int wave; };
__device__ __forceinline__ bool xb_thread0(int wave) { return wave == 0 && __builtin_amdgcn_mbcnt_hi(~0u, __builtin_amdgcn_mbcnt_lo(~0u, 0u)) == 0u; }
__device__ __forceinline__ XcdBarrier xcd_barrier_post(unsigned* bar, volatile LAS unsigned* st, int wave) {
    XcdBarrier b; b.bar = bar; b.x = xb_xcc_id(); b.st = st; b.wave = wave;
    if (xb_thread0(wave)) (void)xb_add(&bar[XB_XCNT(b.x)], 1u);
    return b;
}
__device__ __forceinline__ void xcd_barrier_complete(unsigned* bar, unsigned x, unsigned& nloc, unsigned& nx) {
    const unsigned G = gridDim.x * gridDim.y * gridDim.z;
    unsigned sum, cnt, mine, sp = 0u;
    for (;;) {
        sum = 0u; cnt = 0u; mine = 0u;
#pragma unroll
        for (unsigned j = 0; j < 16; ++j) { const unsigned c = xb_ld(&bar[XB_XCNT(j)]); sum += c; cnt += (c > 0u) ? 1u : 0u; mine = (j == x) ? c : mine; }
        if (sum == G) break;
        __builtin_amdgcn_s_sleep(1);
        if ((++sp & 255u) == 0u) { if (xb_ld(&bar[XB_TMO])) break; if (sp > XB_SPIN_CAP) { atomicAdd(&bar[XB_TMO], 1u); break; } }
    }
    nloc = mine > 0u ? mine : 1u; nx = cnt > 0u ? cnt : 1u;
}
__device__ __forceinline__ void xcd_barrier(const XcdBarrier& b) {
    asm volatile("s_waitcnt vmcnt(0)" ::: "memory");
    __syncthreads();
    if (xb_thread0(b.wave)) {
        unsigned* bar = b.bar; unsigned bx = b.x;
        asm volatile("" : "+s"(bar), "+s"(bx));
        __builtin_amdgcn_s_waitcnt(0);
        unsigned nloc = b.st[0], nx = b.st[1];
        if (nloc == 0u) { xcd_barrier_complete(bar, bx, nloc, nx); b.st[0] = nloc; b.st[1] = nx; }
        const unsigned old = xb_add(&bar[XB_XSUB(bx)], 1u);
        const unsigned gen = old / nloc;
        if (old + 1u == (gen + 1u) * nloc) {
            __builtin_amdgcn_fence(__ATOMIC_RELEASE, "agent");
            asm volatile("s_waitcnt vmcnt(0)" ::: "memory");
            const unsigned og = xb_add(&bar[XB_TOP], 1u);
            const unsigned tg = og / nx;
            if (og + 1u == (tg + 1u) * nx) xb_add(&bar[XB_TOPGEN], 1u);
            else XB_SPIN(xb_ld(&bar[XB_TOPGEN]) == tg, bar);
            __builtin_amdgcn_fence(__ATOMIC_ACQUIRE, "agent");
            xb_add(&bar[XB_XGEN(bx)], 1u);
            asm volatile("s_waitcnt vmcnt(0)" ::: "memory");
        } else {
            XB_SPIN(xb_ld(&bar[XB_XGEN(bx)]) == gen, bar);
            __builtin_amdgcn_fence(__ATOMIC_ACQUIRE, "agent");
            asm volatile("s_waitcnt vmcnt(0)" ::: "memory");
        }
    }
    __syncthreads();
}

struct Args { const void* in[33]; float* out; unsigned char* ws; int ph_lo, ph_hi; };
struct Ctx {
    LAS unsigned char* lds; int tid, lane, wave, bid, G;
};
#define WSP(T_, off) ((T_*)(wsb + (off)))
typedef const __attribute__((address_space(4))) Args* KArgPtr;
__device__ __forceinline__ KArgPtr kargs() { KArgPtr p = (KArgPtr)__builtin_amdgcn_kernarg_segment_ptr(); asm volatile("" : "+s"(p)); return p; }
__device__ __forceinline__ Ctx make_ctx(LAS unsigned char* lds, int wave_s) { Ctx C; int w = wave_s; asm volatile("" : "+s"(w)); int ln; asm volatile("v_mbcnt_lo_u32_b32 %0, -1, 0\n\tv_mbcnt_hi_u32_b32 %0, -1, %0" : "=v"(ln)); C.lds = lds; C.lane = ln; C.wave = w; C.tid = w * 64 + ln; C.bid = blockIdx.x; C.G = gridDim.x; return C; }
#define PHASE_LOCALS __builtin_amdgcn_sched_barrier(0); KArgPtr ka = kargs(); unsigned char* const wsb = ka->ws; (void)wsb; Ctx C = make_ctx(lds0, wave_s)

struct Unit { int pm, pn, g, k; };
__device__ __forceinline__ bool static_tile(int i, int G, int c, int nM, int nN, int& pm, int& pn) {
    const int nwg = nM * nN; const long L = (long)i * G + c; if (L >= nwg) return false;
    int wgid = (int)L; { const int q = nwg / 8, r = nwg % 8, xcd = wgid % 8, off = wgid / 8; wgid = (xcd < r ? xcd * (q + 1) : r * (q + 1) + (xcd - r) * q) + off; }
    const int nig = 8 * nN, gid = wgid / nig, fm = gid * 8, gsz = (nM - fm) < 8 ? (nM - fm) : 8;
    pm = fm + ((wgid % nig) % gsz); pn = (wgid % nig) / gsz; return true;
}
struct PlainSched {
    const bf16* A; const bf16* Bt; int lda, ldb, K, nM, nN, G, c;
    __device__ __forceinline__ bool next(int i, Unit& u) const { u.g = 0; u.k = 0; return static_tile(i, G, c, nM, nN, u.pm, u.pn); }
    __device__ __forceinline__ const char* aptr(const Unit& u) const { return (const char*)(A + (size_t)u.pm * 256 * lda); }
    __device__ __forceinline__ const char* bptr(const Unit& u) const { return (const char*)(Bt + (size_t)u.pn * 256 * ldb); }
};
struct LruSched {
    const bf16* A; const bf16* Bt; int lda, ldb, K, G, c;
    __device__ __forceinline__ bool next(int i, Unit& u) const { u.g = 0; u.k = 0; return static_tile(i, G, c, 32, 8, u.pm, u.pn); }
    __device__ __forceinline__ const char* aptr(const Unit& u) const { return (const char*)(A + (size_t)u.pm * 256 * lda + 256 * (u.pn >> 1)); }
    __device__ __forceinline__ const char* bptr(const Unit& u) const { return (const char*)(Bt + (size_t)u.pn * 256 * ldb); }
};
struct BranchSched {
    const bf16* A; const bf16* Bt; int lda, ldb, K, G, c;
    __device__ __forceinline__ bool next(int i, Unit& u) const { const int tile = c + G * (i / 3); if (tile >= 256) return false; u.g = i % 3; u.k = 0;
        const int x = tile & 7, j = tile >> 3; u.pm = 4 * x + (j >> 3); u.pn = j & 7; return true; }
    __device__ __forceinline__ const char* aptr(const Unit& u) const { return (const char*)(A + ((size_t)u.g * M + (size_t)u.pm * 256) * lda); }
    __device__ __forceinline__ const char* bptr(const Unit& u) const { return (const char*)(Bt + ((size_t)u.g * 2048 + (size_t)u.pn * 256) * ldb); }
};
struct MoeSched {
    const bf16* A; const bf16* Bt; int lda, ldb, K, nN, GP, KS, G, c; const int* blke; const int* bstart; int nused; size_t estride;
    __device__ __forceinline__ bool next(int i, Unit& u) const {
        const int nwg = nused * nN * KS; const long L = (long)i * G + c; if (L >= nwg) return false;
        int p = (int)L; { const int q = nwg / 8, r = nwg % 8, xcd = p % 8, off = p / 8; p = (xcd < r ? xcd * (q + 1) : r * (q + 1) + (xcd - r) * q) + off; }
        int e = 0, b0 = 0, b1 = __builtin_amdgcn_readfirstlane(bstart[1]);
#pragma unroll
        for (int j = 1; j < 8; ++j) { const int bj = __builtin_amdgcn_readfirstlane(bstart[j]), bn = __builtin_amdgcn_readfirstlane(bstart[j + 1]); if (p >= bj * nN * KS) { e = j; b0 = bj; b1 = bn; } }
        const int nb = b1 - b0, qq = p - b0 * nN * KS, ks = qq / (nb * nN), q = qq - ks * (nb * nN), per = nb * GP, g4 = q / per, rem = q - g4 * per, bl = rem / GP, pl = rem - bl * GP;
        u.pm = b0 + bl; u.pn = g4 * GP + pl; u.g = e; u.k = ks; return true;
    }
    __device__ __forceinline__ const char* aptr(const Unit& u) const { return (const char*)(A + (size_t)u.pm * 256 * lda + (size_t)u.k * K); }
    __device__ __forceinline__ const char* bptr(const Unit& u) const { return (const char*)(Bt + (size_t)u.g * estride + (size_t)u.pn * 256 * ldb + (size_t)u.k * K); }
};

struct EpiNoCol { };
struct EpiBf16 { static constexpr bool DUAL = false, PRELOAD = false; bf16* O; int ldc; int coff; float sc;
    __device__ __forceinline__ void store(const Unit& u, int r, int c, f32x4 v) const {
        u32x2 w; w.x = pk2(v[0] * sc, v[1] * sc); w.y = pk2(v[2] * sc, v[3] * sc); *(u32x2*)(O + (size_t)(u.pm * 256 + r) * ldc + coff + u.pn * 256 + c) = w; } };
struct EpiLru { static constexpr bool DUAL = true, PRELOAD = true; bf16* la; bf16* lb; const bf16* xc; const float* ba; const float* bx; const float* sp8;
    struct Data { u32x2 xw; }; struct Col { f32x4 ba4, bx4, sp4; };
    __device__ __forceinline__ Col cload(const Unit& u, int c) const { const int col = u.pn * 128 + c; Col q; q.ba4 = *(const f32x4*)(ba + col); q.bx4 = *(const f32x4*)(bx + col); q.sp4 = *(const f32x4*)(sp8 + col); return q; }
    __device__ __forceinline__ Data load(const Unit& u, int r, int c) const { Data d; d.xw = *(const u32x2*)(xc + (size_t)(u.pm * 256 + r) * 1024 + u.pn * 128 + c); return d; }
    __device__ __forceinline__ void store2(const Unit& u, int r, int c, f32x4 g, f32x4 up, const Data& d, const Col& q) const {
        const int row = u.pm * 256 + r, col = u.pn * 128 + c; f32x4 a1, b;
        const float xv[4] = {bflo(d.xw.x), bfhi(d.xw.x), bflo(d.xw.y), bfhi(d.xw.y)};
#pragma unroll
        for (int j = 0; j < 4; ++j) { const float rr = sigmoidf_(g[j] + q.ba4[j]), ii = sigmoidf_(up[j] + q.bx4[j]);
            const float aa = __expf(-rr * q.sp4[j]); a1[j] = 1.0f - aa; b[j] = sqrtf(fmaxf(1.0f - aa * aa, 0.f)) * (ii * xv[j]); }
        u32x2 wa, wb; wa.x = pk2(a1[0], a1[1]); wa.y = pk2(a1[2], a1[3]); wb.x = pk2(b[0], b[1]); wb.y = pk2(b[2], b[3]);
        *(u32x2*)(la + (size_t)row * 1024 + col) = wa; *(u32x2*)(lb + (size_t)row * 1024 + col) = wb; }
    __device__ __forceinline__ void store2(const Unit& u, int r, int c, f32x4 g, f32x4 up) const { store2(u, r, c, g, up, load(u, r, c), cload(u, c)); } };
struct EpiBranch { static constexpr bool DUAL = false, PRELOAD = true; const bf16* proj; bf16* mf; bf16* mg;
    struct Data { u32x2 gw, pw; }; typedef EpiNoCol Col;
    __device__ __forceinline__ Col cload(const Unit&, int) const { return Col{}; }
    __device__ __forceinline__ Data load(const Unit& u, int r, int c) const { const int row = u.pm * 256 + r, col = u.pn * 256 + c; Data d;
        d.gw = *(const u32x2*)(proj + (size_t)row * PROJ_N + PX_GATE + u.g * 2048 + col); d.pw = (u32x2){0u, 0u}; if (u.g != 0) d.pw = *(const u32x2*)(mf + (size_t)row * D + col); return d; }
    __device__ __forceinline__ void store(const Unit& u, int r, int c, f32x4 v, const Data& d, const Col&) const {
        const int row = u.pm * 256 + r, col = u.pn * 256 + c;
        f32x4 o; o[0] = v[0] * sigmoidf_(bflo(d.gw.x)) + bflo(d.pw.x); o[1] = v[1] * sigmoidf_(bfhi(d.gw.x)) + bfhi(d.pw.x); o[2] = v[2] * sigmoidf_(bflo(d.gw.y)) + bflo(d.pw.y); o[3] = v[3] * sigmoidf_(bfhi(d.gw.y)) + bfhi(d.pw.y);
        u32x2 w; w.x = pk2(o[0], o[1]); w.y = pk2(o[2], o[3]);
        *(u32x2*)((u.g == 2 ? mg : mf) + (size_t)row * D + col) = w; }
    __device__ __forceinline__ void store(const Unit& u, int r, int c, f32x4 v) const { store(u, r, c, v, load(u, r, c), Col{}); } };
template <bool BIN, bool BOUT> struct EpiResidT { static constexpr bool DUAL = false, PRELOAD = true; const void* base; void* out; int ldc; float sc;
    struct Data { f32x4 bv; }; typedef EpiNoCol Col;
    __device__ __forceinline__ Col cload(const Unit&, int) const { return Col{}; }
    __device__ __forceinline__ Data load(const Unit& u, int r, int c) const { const size_t o = (size_t)(u.pm * 256 + r) * ldc + u.pn * 256 + c; Data d;
        if (BIN) { const u32x2 w = *(const u32x2*)((const bf16*)base + o); d.bv = (f32x4){bflo(w.x), bfhi(w.x), bflo(w.y), bfhi(w.y)}; } else d.bv = *(const f32x4*)((const float*)base + o); return d; }
    __device__ __forceinline__ void store(const Unit& u, int r, int c, f32x4 v, const Data& d, const Col&) const {
        const size_t o = (size_t)(u.pm * 256 + r) * ldc + u.pn * 256 + c; const f32x4 y = d.bv + v * sc;
        if (BOUT) { u32x2 w; w.x = pk2(y[0], y[1]); w.y = pk2(y[2], y[3]); *(u32x2*)((bf16*)out + o) = w; } else *(f32x4*)((float*)out + o) = y; }
    __device__ __forceinline__ void store(const Unit& u, int r, int c, f32x4 v) const { store(u, r, c, v, load(u, r, c), Col{}); } };
struct EpiSwiglu { static constexpr bool DUAL = true, PRELOAD = false; bf16* O; int ldo;
    __device__ __forceinline__ void store2(const Unit& u, int r, int c, f32x4 g, f32x4 up) const {
        f32x4 o;
#pragma unroll
        for (int j = 0; j < 4; ++j) o[j] = g[j] * sigmoidf_(g[j]) * up[j];
        u32x2 w; w.x = pk2(o[0], o[1]); w.y = pk2(o[2], o[3]); *(u32x2*)(O + (size_t)(u.pm * 256 + r) * ldo + u.pn * 128 + c) = w; } };
struct EpiSwigluF8 { static constexpr bool DUAL = true, PRELOAD = false; unsigned char* O; int ldo; float sin;
    __device__ __forceinline__ void store2(const Unit& u, int r, int c, f32x4 g, f32x4 up) const {
        f32x4 o;
#pragma unroll
        for (int j = 0; j < 4; ++j) { const float gg = g[j] * sin, uu = up[j] * sin; o[j] = gg * sigmoidf_(gg) * uu * F8_HSCALE; }
        *(unsigned*)(O + (size_t)(u.pm * 256 + r) * ldo + u.pn * 128 + c) = pk4_fp8(o[0], o[1], o[2], o[3]); } };
struct EpiScaleRow { static constexpr bool DUAL = false, PRELOAD = true; bf16* ys; const float* rowg; float sc;
    struct Data { float g; }; typedef EpiNoCol Col;
    __device__ __forceinline__ Col cload(const Unit&, int) const { return Col{}; }
    __device__ __forceinline__ Data load(const Unit& u, int r, int) const { Data d; d.g = rowg[u.pm * 256 + r]; return d; }
    __device__ __forceinline__ void store(const Unit& u, int r, int c, f32x4 v, const Data& d, const Col&) const {
        const int row = u.pm * 256 + r; const float gs = d.g * sc; u32x2 w; w.x = pk2(v[0] * gs, v[1] * gs); w.y = pk2(v[2] * gs, v[3] * gs);
        *(u32x2*)(ys + (size_t)u.k * MOE_ROWS * D + (size_t)row * D + u.pn * 256 + c) = w; }
    __device__ __forceinline__ void store(const Unit& u, int r, int c, f32x4 v) const { store(u, r, c, v, load(u, r, c), Col{}); } };
template <bool BOUT> struct EpiPleT { static constexpr bool DUAL = false, PRELOAD = true; const bf16* hin; void* hout; const bf16* pp;
    struct Data { u32x2 pw, hw; }; typedef EpiNoCol Col;
    __device__ __forceinline__ Col cload(const Unit&, int) const { return Col{}; }
    __device__ __forceinline__ Data load(const Unit& u, int r, int c) const { const size_t o = (size_t)(u.pm * 256 + r) * D + u.pn * 256 + c; Data d; d.pw = *(const u32x2*)(pp + o); d.hw = *(const u32x2*)(hin + o); return d; }
    __device__ __forceinline__ void store(const Unit& u, int r, int c, f32x4 v, const Data& d, const Col&) const {
        const size_t o = (size_t)(u.pm * 256 + r) * D + u.pn * 256 + c;
        f32x4 y; y[0] = bflo(d.hw.x) + bflo(d.pw.x) * sigmoidf_(v[0]); y[1] = bfhi(d.hw.x) + bfhi(d.pw.x) * sigmoidf_(v[1]); y[2] = bflo(d.hw.y) + bflo(d.pw.y) * sigmoidf_(v[2]); y[3] = bfhi(d.hw.y) + bfhi(d.pw.y) * sigmoidf_(v[3]);
        if (BOUT) { u32x2 w; w.x = pk2(y[0], y[1]); w.y = pk2(y[2], y[3]); *(u32x2*)((bf16*)hout + o) = w; } else *(f32x4*)((float*)hout + o) = y; }
    __device__ __forceinline__ void store(const Unit& u, int r, int c, f32x4 v) const { store(u, r, c, v, load(u, r, c), Col{}); } };

template <class Epi, class Sched>
__device__ __forceinline__ void gemm_naive(LAS unsigned char* lds, int tid, const Sched& S, const Epi& E) {
    LAS float* As = (LAS float*)lds;
    LAS float* Bs = (LAS float*)(lds + 4096);
    const int tx = tid & 31, ty = tid >> 5;
    const int lrow = tid >> 1, lk = (tid & 1) * 8;
    Unit u;
    for (int i = 0; S.next(i, u); ++i) {
        const bf16* A0 = (const bf16*)S.aptr(u); const bf16* B0 = (const bf16*)S.bptr(u);
        for (int rc = 0; rc < 4; ++rc) {
            f32x4 lo[4], hi[4];
#pragma unroll
            for (int q = 0; q < 4; ++q) { lo[q] = (f32x4){0.f, 0.f, 0.f, 0.f}; hi[q] = (f32x4){0.f, 0.f, 0.f, 0.f}; }
            for (int k0 = 0; k0 < S.K; k0 += 16) {
                __syncthreads();
                { const u32x4 bv = *(const u32x4*)(B0 + (size_t)lrow * S.ldb + k0 + lk);
                  const float f[8] = {bflo(bv.x), bfhi(bv.x), bflo(bv.y), bfhi(bv.y), bflo(bv.z), bfhi(bv.z), bflo(bv.w), bfhi(bv.w)};
#pragma unroll
                  for (int j = 0; j < 8; ++j) Bs[(lk + j) * 256 + lrow] = f[j]; }
                if (tid < 128) { const u32x4 av = *(const u32x4*)(A0 + (size_t)(rc * 64 + lrow) * S.lda + k0 + lk);
                  const float f[8] = {bflo(av.x), bfhi(av.x), bflo(av.y), bfhi(av.y), bflo(av.z), bfhi(av.z), bflo(av.w), bfhi(av.w)};
#pragma unroll
                  for (int j = 0; j < 8; ++j) As[(lk + j) * 64 + lrow] = f[j]; }
                __syncthreads();
#pragma unroll
                for (int k = 0; k < 16; ++k) {
                    const f32x4 a = *(const LAS f32x4*)(As + k * 64 + 4 * ty), b0 = *(const LAS f32x4*)(Bs + k * 256 + 4 * tx), b1 = *(const LAS f32x4*)(Bs + k * 256 + 128 + 4 * tx);
#pragma unroll
                    for (int q = 0; q < 4; ++q) { lo[q] += b0 * a[q]; hi[q] += b1 * a[q]; }
                }
            }
#pragma unroll
            for (int q = 0; q < 4; ++q) { const int r = rc * 64 + 4 * ty + q;
                if constexpr (Epi::DUAL) E.store2(u, r, 4 * tx, lo[q], hi[q]);
                else { E.store(u, r, 4 * tx, lo[q]); E.store(u, r, 128 + 4 * tx, hi[q]); } }
        }
    }
    __syncthreads();
}

namespace pg8 {
constexpr int BK = 64, HALF = 128, HTB = HALF * BK * 2;
__device__ __forceinline__ int lds_byte(int r, int c) { const int st = (r >> 4) * 2 + (c >> 5), rr = r & 15, cc = c & 31, ob = rr * 64 + cc * 2; return st * 1024 + (ob ^ (((ob >> 9) & 1) << 5)); }
__device__ __forceinline__ void stage_rc(int b, int& R, int& C) { const int st = b / 1024, sb = b % 1024, swz = sb ^ (((sb >> 9) & 1) << 5); R = (st >> 1) * 16 + swz / 64; C = (st & 1) * 32 + (swz % 64) / 2; }
template <class Epi, class Sched, bool FP8 = false>
__device__ __forceinline__ void gemm_phase(LAS unsigned char* lds, int tid, const Sched& S, const Epi& E) {
    const int wid = __builtin_amdgcn_readfirstlane(tid >> 6), lane = tid & 63, wr = wid >> 2, wc = wid & 3, fr = lane & 15, fq = lane >> 4;
    const int nt = S.K / BK;
    unsigned voffA[2], voffB[2];
#pragma unroll
    for (int i = 0; i < 2; ++i) { int R, Cc; stage_rc(tid * 16 + i * 8192, R, Cc); const int rho = R & 31, Rb = (R & ~31) + 8 * ((rho & 15) >> 2) + 4 * (rho >> 4) + (rho & 3);
        voffA[i] = (unsigned)(R * S.lda + Cc) * 2u; voffB[i] = (unsigned)(Rb * S.ldb + Cc) * 2u; }
    const size_t kstep = (size_t)(BK * 2);
    const size_t hstepA = (size_t)HALF * S.lda * 2, hstepB = (size_t)HALF * S.ldb * 2;
    const unsigned ldsw = (unsigned)wid * 1024u;
    const int aoff = lds_byte(wr * 64 + fr, fq * 8), boff = lds_byte(wc * 32 + fr, fq * 8);
#define PG8_SA(b, h) (((b) * 2 + (h)) * HTB)
#define PG8_SB(b, h) ((4 + (b) * 2 + (h)) * HTB)
#define PG8_STAGE(bufoff, gbase, voff) do { _Pragma("unroll") for (int _i = 0; _i < 2; ++_i) \
        __builtin_amdgcn_global_load_lds((const unsigned*)((const char*)(gbase) + (voff)[_i]), (LAS unsigned*)(lds + (bufoff) + ldsw + _i * 8192), 16, 0, 0); } while (0)
#define PG8_LDA(dst, b, h) do { _Pragma("unroll") for (int m = 0; m < 4; ++m) _Pragma("unroll") for (int k = 0; k < 2; ++k) dst[m][k] = *(const LAS bf16x8*)(lds + PG8_SA(b, h) + aoff + m * 2048 + k * 1024); } while (0)
#define PG8_LDB(dst, b, h) do { _Pragma("unroll") for (int n = 0; n < 2; ++n) _Pragma("unroll") for (int k = 0; k < 2; ++k) dst[n][k] = *(const LAS bf16x8*)(lds + PG8_SB(b, h) + boff + n * 2048 + k * 1024); } while (0)
#define PG8_MMA(ai, bj, At, Bt) do { __builtin_amdgcn_s_setprio(1); _Pragma("unroll") for (int m = 0; m < 4; ++m) _Pragma("unroll") for (int n = 0; n < 2; ++n) { \
        if constexpr (FP8) { typedef int v8i_ __attribute__((ext_vector_type(8))); typedef int v4i_ __attribute__((ext_vector_type(4))); \
            const v4i_ b0_ = __builtin_bit_cast(v4i_, Bt[n][0]), b1_ = __builtin_bit_cast(v4i_, Bt[n][1]), a0_ = __builtin_bit_cast(v4i_, At[m][0]), a1_ = __builtin_bit_cast(v4i_, At[m][1]); \
            const v8i_ bb_ = {b0_[0], b0_[1], b0_[2], b0_[3], b1_[0], b1_[1], b1_[2], b1_[3]}, aa_ = {a0_[0], a0_[1], a0_[2], a0_[3], a1_[0], a1_[1], a1_[2], a1_[3]}; \
            asm volatile("v_mfma_scale_f32_16x16x128_f8f6f4 %0, %1, %2, %0, %3, %3 op_sel_hi:[0,0,0]" : "+v"(acc[ai][bj][m][n]) : "v"(bb_), "v"(aa_), "v"(f8scale)); } \
        else { _Pragma("unroll") for (int k = 0; k < 2; ++k) acc[ai][bj][m][n] = __builtin_amdgcn_mfma_f32_16x16x32_bf16(Bt[n][k], At[m][k], acc[ai][bj][m][n], 0, 0, 0); } } \
        __builtin_amdgcn_s_setprio(0); } while (0)
#define PG8_WAIT_V(n) asm volatile("s_waitcnt vmcnt(" #n ")" ::: "memory")
#define PG8_WAIT_L(n) asm volatile("s_waitcnt lgkmcnt(" #n ")" ::: "memory")
#define PG8_BAR __builtin_amdgcn_s_barrier()
#define PG8_SCHED __builtin_amdgcn_sched_barrier(0)
    Unit cur, nxt; int ui = 0;
    if (!S.next(0, cur)) return;
    f32x4 acc[2][2][4][2];
#pragma unroll
    for (int a = 0; a < 2; ++a)
#pragma unroll
        for (int b = 0; b < 2; ++b)
#pragma unroll
            for (int m = 0; m < 4; ++m)
#pragma unroll
                for (int n = 0; n < 2; ++n) acc[a][b][m][n] = (f32x4){0.f, 0.f, 0.f, 0.f};
    bf16x8 At[4][2], B0[2][2], B1[2][2];
    const int f8scale = 0x7f7f7f7f; (void)f8scale;
    const char* cA = S.aptr(cur); const char* cB = S.bptr(cur);
    PG8_STAGE(PG8_SB(0, 0), cB, voffB); PG8_STAGE(PG8_SB(0, 1), cB + hstepB, voffB); PG8_STAGE(PG8_SA(0, 0), cA, voffA); PG8_STAGE(PG8_SA(0, 1), cA + hstepA, voffA);
    if (wr == 1) PG8_BAR;
    PG8_WAIT_V(2); PG8_BAR;
    PG8_STAGE(PG8_SB(1, 0), cB + kstep, voffB); PG8_STAGE(PG8_SA(1, 0), cA + kstep, voffA); PG8_STAGE(PG8_SB(1, 1), cB + hstepB + kstep, voffB);
    PG8_WAIT_V(6); PG8_BAR;
    for (;;) {
        const bool has_next = S.next(ui + 1, nxt);
        const char* nA = has_next ? S.aptr(nxt) : cA; const char* nB = has_next ? S.bptr(nxt) : cB;
        for (int t = 0; t < nt; t += 2) {
            const bool last = (t == nt - 2);
            const char* a1 = cA + (size_t)(t + 1) * kstep;
            const char* a2 = last ? nA : cA + (size_t)(t + 2) * kstep; const char* b2 = last ? nB : cB + (size_t)(t + 2) * kstep;
            const char* a3 = a2 + kstep; const char* b3 = b2 + kstep;
            PG8_LDB(B0, 0, 0); PG8_LDB(B1, 0, 1); PG8_SCHED; PG8_LDA(At, 0, 0); PG8_STAGE(PG8_SA(1, 1), a1 + hstepA, voffA);
            PG8_WAIT_V(8); PG8_WAIT_L(0); PG8_BAR; PG8_MMA(0, 0, At, B0); PG8_MMA(0, 1, At, B1); PG8_BAR; PG8_SCHED;
            PG8_LDA(At, 0, 1); PG8_STAGE(PG8_SB(0, 0), b2, voffB); PG8_STAGE(PG8_SB(0, 1), b2 + hstepB, voffB); PG8_STAGE(PG8_SA(0, 0), a2, voffA);
            PG8_WAIT_V(8); PG8_WAIT_L(0); PG8_BAR; PG8_MMA(1, 0, At, B0); PG8_MMA(1, 1, At, B1); PG8_BAR; PG8_SCHED;
            PG8_LDB(B0, 1, 0); PG8_LDB(B1, 1, 1); PG8_SCHED; PG8_LDA(At, 1, 0); PG8_STAGE(PG8_SA(0, 1), a2 + hstepA, voffA);
            PG8_WAIT_V(8); PG8_WAIT_L(0); PG8_BAR; PG8_MMA(0, 0, At, B0); PG8_MMA(0, 1, At, B1); PG8_BAR; PG8_SCHED;
            PG8_LDA(At, 1, 1); PG8_STAGE(PG8_SB(1, 0), b3, voffB); PG8_STAGE(PG8_SB(1, 1), b3 + hstepB, voffB); PG8_STAGE(PG8_SA(1, 0), a3, voffA);
            PG8_WAIT_V(8); PG8_WAIT_L(0); PG8_BAR; PG8_MMA(1, 0, At, B0); PG8_MMA(1, 1, At, B1); PG8_BAR; PG8_SCHED;
        }
        if (wr == 0) PG8_BAR;
        if constexpr (FP8) asm volatile("s_nop 15\n\ts_nop 15" ::: "memory");
        Unit eu; eu.pm = __builtin_amdgcn_readfirstlane(cur.pm); eu.pn = __builtin_amdgcn_readfirstlane(cur.pn); eu.g = __builtin_amdgcn_readfirstlane(cur.g); eu.k = __builtin_amdgcn_readfirstlane(cur.k); asm volatile("" : "+s"(eu.pm), "+s"(eu.pn), "+s"(eu.g), "+s"(eu.k));
        if constexpr (Epi::PRELOAD) {
            typename Epi::Col cv[2];
#pragma unroll
            for (int n = 0; n < 2; ++n) cv[n] = E.cload(eu, wc * 32 + 8 * fq + 4 * n);
            constexpr int NB = Epi::DUAL ? 2 : 4;
            typename Epi::Data dd[2][8];
#define PG8_EPI_LOAD(b_, slot_) do { _Pragma("unroll") for (int j_ = 0; j_ < 8; ++j_) { int ai_, m_, bj_, n_; \
                if constexpr (Epi::DUAL) { ai_ = (b_); m_ = j_ >> 1; bj_ = 0; n_ = j_ & 1; } else { ai_ = (b_) >> 1; m_ = 2 * ((b_) & 1) + (j_ >> 2); bj_ = (j_ >> 1) & 1; n_ = j_ & 1; } \
                dd[slot_][j_] = E.load(eu, ai_ * 128 + wr * 64 + m_ * 16 + fr, bj_ * 128 + wc * 32 + 8 * fq + 4 * n_); } } while (0)
            PG8_EPI_LOAD(0, 0);
#pragma unroll
            for (int b = 0; b < NB; ++b) {
                if (b + 1 < NB) PG8_EPI_LOAD(b + 1, (b + 1) & 1);
#pragma unroll
                for (int j = 0; j < 8; ++j) { int ai, m, bj, n;
                    if constexpr (Epi::DUAL) { ai = b; m = j >> 1; bj = 0; n = j & 1; } else { ai = b >> 1; m = 2 * (b & 1) + (j >> 2); bj = (j >> 1) & 1; n = j & 1; }
                    const int r = ai * 128 + wr * 64 + m * 16 + fr, c = wc * 32 + 8 * fq + 4 * n;
                    if constexpr (Epi::DUAL) E.store2(eu, r, c, acc[ai][0][m][n], acc[ai][1][m][n], dd[b & 1][j], cv[n]);
                    else E.store(eu, r, bj * 128 + c, acc[ai][bj][m][n], dd[b & 1][j], cv[n]); }
            }
#undef PG8_EPI_LOAD
        } else {
#pragma unroll
        for (int ai = 0; ai < 2; ++ai)
#pragma unroll
            for (int m = 0; m < 4; ++m) { const int r = ai * 128 + wr * 64 + m * 16 + fr;
                if constexpr (Epi::DUAL) {
#pragma unroll
                    for (int n = 0; n < 2; ++n) E.store2(eu, r, wc * 32 + 8 * fq + 4 * n, acc[ai][0][m][n], acc[ai][1][m][n]);
                } else {
#pragma unroll
                    for (int bj = 0; bj < 2; ++bj)
#pragma unroll
                        for (int n = 0; n < 2; ++n) E.store(eu, r, bj * 128 + wc * 32 + 8 * fq + 4 * n, acc[ai][bj][m][n]); } }
        }
        if (!has_next) break;
#pragma unroll
        for (int a = 0; a < 2; ++a)
#pragma unroll
            for (int b = 0; b < 2; ++b)
#pragma unroll
                for (int m = 0; m < 4; ++m)
#pragma unroll
                    for (int n = 0; n < 2; ++n) acc[a][b][m][n] = (f32x4){0.f, 0.f, 0.f, 0.f};
        cur = nxt; cA = nA; cB = nB; ++ui;
        if (wr == 1) PG8_BAR;
    }
    PG8_WAIT_V(0);
    PG8_BAR;
#undef PG8_SA
#undef PG8_SB
#undef PG8_STAGE
#undef PG8_LDA
#undef PG8_LDB
#undef PG8_MMA
#undef PG8_WAIT_V
#undef PG8_WAIT_L
#undef PG8_BAR
#undef PG8_SCHED
}
}

template <class Epi, class Sched>
__device__ __forceinline__ void gemm_run_fp8(Ctx& C, const Sched& S, const Epi& E) { pg8::gemm_phase<Epi, Sched, true>(C.lds, C.tid, S, E); }
template <class Epi, class Sched>
__device__ __forceinline__ void gemm_run(Ctx& C, const Sched& S, const Epi& E) {
#if FAST_GEMM
    pg8::gemm_phase<Epi, Sched>(C.lds, C.tid, S, E);
#else
    gemm_naive<Epi, Sched>(C.lds, C.tid, S, E);
#endif
}

__device__ __forceinline__ int win_col(int n) {
    if (n < 6144) return n;
    if (n < 6912) return 6224 + (n - 6144);
    if (n < 7424) return 6992 + (n - 6912);
    if (n < 7488) return 6144 + (n - 7424);
    if (n < 7552) return 7504 + (n - 7488);
    if (n < 7568) return 6208 + (n - 7552);
    if (n < 7680) return -1;
    return 7568 + (n - 7680);
}
struct RsPlain { const float* s; __device__ __forceinline__ const float* operator()(int n) const { return s + n; } };
struct RsWin { const float* s; __device__ __forceinline__ const float* operator()(int n) const { const int c = win_col(n); return c < 0 ? nullptr : s + c; } };
struct RsGU { const float* g; ptrdiff_t du; __device__ __forceinline__ const float* operator()(int n) const { const int tile = n >> 8, r = n & 255; return g + (r < 128 ? (ptrdiff_t)0 : du) + tile * 128 + (r & 127); } };
template <class RS>
__device__ __forceinline__ void conv_job(Ctx& C, bf16* dst, int nrows, int K, int srcN, const RS& rs) {
#if FAST_CONV
    LAS unsigned char* tile = C.lds;
    const int nkb = K / 64, nitems = (nrows / 256) * nkb, w = C.wave, L = C.lane, tid = C.tid;
    f32x4 v[8], vn[8]; float zf = 1.f, zfn = 1.f;
#define CJ_LOAD(it_, dst_, z_) do { const int nb_ = (it_) / nkb, kb_ = (it_) % nkb; const float* sp_ = rs(nb_ * 256 + 4 * L); z_ = sp_ ? 1.f : 0.f; sp_ = sp_ ? sp_ : rs(0); \
        _Pragma("unroll") for (int j = 0; j < 8; ++j) dst_[j] = __builtin_nontemporal_load((const f32x4*)(sp_ + (size_t)(kb_ * 64 + 8 * w + j) * srcN)); } while (0)
#define CJ_PROC(it_, src_, z_) do { const int nb_ = (it_) / nkb, kb_ = (it_) % nkb, n0_ = nb_ * 256, k0_ = kb_ * 64; \
        asm volatile("s_waitcnt lgkmcnt(0)" ::: "memory"); __builtin_amdgcn_s_barrier();     \
        _Pragma("unroll") for (int q = 0; q < 4; ++q) { u32x4 o; o.x = pk2(src_[0][q] * z_, src_[1][q] * z_); o.y = pk2(src_[2][q] * z_, src_[3][q] * z_); o.z = pk2(src_[4][q] * z_, src_[5][q] * z_); o.w = pk2(src_[6][q] * z_, src_[7][q] * z_); \
            *(LAS u32x4*)(tile + (4 * L + q) * 144 + w * 16) = o; } \
        asm volatile("s_waitcnt lgkmcnt(0)" ::: "memory"); __builtin_amdgcn_s_barrier(); \
        _Pragma("unroll") for (int i = 0; i < 4; ++i) { const int idx = tid + 512 * i, n = idx >> 3, ch = idx & 7; const u32x4 o = *(const LAS u32x4*)(tile + n * 144 + ch * 16); *(u32x4*)(dst + (size_t)(n0_ + n) * K + k0_ + ch * 8) = o; } } while (0)
    int it = C.bid;
    if (it < nitems) {
        CJ_LOAD(it, v, zf);
        for (;;) {
            { const int nx = it + C.G, nc = nx < nitems ? nx : nitems - 1; CJ_LOAD(nc, vn, zfn); CJ_PROC(it, v, zf); it = nx; if (it >= nitems) break; }
            { const int nx = it + C.G, nc = nx < nitems ? nx : nitems - 1; CJ_LOAD(nc, v, zf); CJ_PROC(it, vn, zfn); it = nx; if (it >= nitems) break; }
        }
    }
#undef CJ_LOAD
#undef CJ_PROC
    __syncthreads();
#else
    const size_t tot = (size_t)nrows * K, gsz = (size_t)C.G * 512;
    for (size_t i = (size_t)C.bid * 512 + C.tid; i < tot; i += gsz) { const int k = (int)(i / nrows), n = (int)(i % nrows); const float* sp = rs(n);
        dst[(size_t)n * K + k] = sp ? f2bf(sp[(size_t)k * srcN]) : (bf16)0; }
#endif
}

template <class RS>
__device__ __forceinline__ void conv_job_fp8(Ctx& C, unsigned char* dst, int nrows, int K, int srcN, const RS& rs, float scale) {
    LAS unsigned char* tile = C.lds;
    const int nkb = K / 128, nitems = (nrows / 256) * nkb, w = C.wave, L = C.lane, tid = C.tid;
    f32x4 v[16], vn[16];
#define CJ_LOAD8(it_, dst_) do { const int nb_ = (it_) / nkb, kb_ = (it_) % nkb; const float* sp_ = rs(nb_ * 256 + 4 * L); _Pragma("unroll") for (int j = 0; j < 16; ++j) \
        dst_[j] = __builtin_nontemporal_load((const f32x4*)(sp_ + (size_t)(kb_ * 128 + 16 * w + j) * srcN)); } while (0)
#define CJ_PROC8(it_, src_) do { const int nb_ = (it_) / nkb, kb_ = (it_) % nkb, n0_ = nb_ * 256, k0_ = kb_ * 128; \
        asm volatile("s_waitcnt lgkmcnt(0)" ::: "memory"); __builtin_amdgcn_s_barrier(); \
        _Pragma("unroll") for (int q = 0; q < 4; ++q) { u32x4 o; o.x = pk4_fp8(src_[0][q] * scale, src_[1][q] * scale, src_[2][q] * scale, src_[3][q] * scale); o.y = pk4_fp8(src_[4][q] * scale, src_[5][q] * scale, src_[6][q] * scale, src_[7][q] * scale); \
            o.z = pk4_fp8(src_[8][q] * scale, src_[9][q] * scale, src_[10][q] * scale, src_[11][q] * scale); o.w = pk4_fp8(src_[12][q] * scale, src_[13][q] * scale, src_[14][q] * scale, src_[15][q] * scale); \
            *(LAS u32x4*)(tile + (4 * L + q) * 144 + w * 16) = o; } \
        asm volatile("s_waitcnt lgkmcnt(0)" ::: "memory"); __builtin_amdgcn_s_barrier(); \
        _Pragma("unroll") for (int i = 0; i < 4; ++i) { const int idx = tid + 512 * i, n = idx >> 3, ch = idx & 7; const u32x4 o = *(const LAS u32x4*)(tile + n * 144 + ch * 16); *(u32x4*)(dst + (size_t)(n0_ + n) * K + k0_ + ch * 16) = o; } } while (0)
    int it = C.bid;
    if (it < nitems) {
        CJ_LOAD8(it, v);
        for (;;) {
            { const int nx = it + C.G, nc = nx < nitems ? nx : nitems - 1; CJ_LOAD8(nc, vn); CJ_PROC8(it, v); it = nx; if (it >= nitems) break; }
            { const int nx = it + C.G, nc = nx < nitems ? nx : nitems - 1; CJ_LOAD8(nc, v); CJ_PROC8(it, vn); it = nx; if (it >= nitems) break; }
        }
    }
#undef CJ_LOAD8
#undef CJ_PROC8
    __syncthreads();
}

template <bool ROUTER, int OUT8 = 0, bool SRC16 = true>
__device__ __forceinline__ void rmsnorm_rows(Ctx& C, const void* src, const float* gain, bf16* dst, const float* router, int* toke, float* tokg, unsigned char* dst8 = nullptr) {
    const int gw = C.bid * 8 + C.wave, NGW = C.G * 8, lane = C.lane;
    for (int m = gw; m < M; m += NGW) {
        f32x4 v[8]; float ss = 0.f;
#pragma unroll
        for (int j = 0; j < 8; ++j) { if (SRC16) { const u32x2 w = ((const u32x2*)((const bf16*)src + (size_t)m * D))[lane + 64 * j]; v[j] = (f32x4){bflo(w.x), bfhi(w.x), bflo(w.y), bfhi(w.y)}; } else v[j] = ((const f32x4*)((const float*)src + (size_t)m * D))[lane + 64 * j];
            ss += (v[j][0] * v[j][0] + v[j][1] * v[j][1]) + (v[j][2] * v[j][2] + v[j][3] * v[j][3]); }
        const float rstd = 1.0f / sqrtf(wave_sum(ss) * (1.0f / D) + EPS);
        float lg[8];
        if (ROUTER) {
#pragma unroll
            for (int e = 0; e < 8; ++e) lg[e] = 0.f; }
#pragma unroll
        for (int j = 0; j < 8; ++j) { const f32x4 g4 = ((const f32x4*)gain)[lane + 64 * j]; const f32x4 y = v[j] * rstd * g4;
            if (OUT8 == 1) { *(unsigned*)((unsigned char*)dst + (size_t)m * D + 4 * (lane + 64 * j)) = pk4_fp8(y[0] * F8_XSCALE, y[1] * F8_XSCALE, y[2] * F8_XSCALE, y[3] * F8_XSCALE); }
            else { u32x2 w; w.x = pk2(y[0], y[1]); w.y = pk2(y[2], y[3]); *(u32x2*)(dst + (size_t)m * D + 4 * (lane + 64 * j)) = w;
                if (OUT8 == 2) *(unsigned*)(dst8 + (size_t)m * D + 4 * (lane + 64 * j)) = pk4_fp8(y[0] * F8_XSCALE, y[1] * F8_XSCALE, y[2] * F8_XSCALE, y[3] * F8_XSCALE); }
            if (ROUTER) {
#pragma unroll
                for (int q = 0; q < 4; ++q) { const f32x4* rp = (const f32x4*)(router + (size_t)(4 * (lane + 64 * j) + q) * 8); const f32x4 r0 = rp[0], r1 = rp[1];
                    lg[0] += y[q] * r0[0]; lg[1] += y[q] * r0[1]; lg[2] += y[q] * r0[2]; lg[3] += y[q] * r0[3]; lg[4] += y[q] * r1[0]; lg[5] += y[q] * r1[1]; lg[6] += y[q] * r1[2]; lg[7] += y[q] * r1[3]; } } }
        if (ROUTER) {
#pragma unroll
            for (int e = 0; e < 8; ++e) lg[e] = wave_sum(lg[e]);
            int e0 = 0; float v0 = lg[0];
#pragma unroll
            for (int e = 1; e < 8; ++e) if (lg[e] > v0) { v0 = lg[e]; e0 = e; }
            int e1 = -1; float v1 = -INFINITY;
#pragma unroll
            for (int e = 0; e < 8; ++e) if (e != e0 && lg[e] > v1) { v1 = lg[e]; e1 = e; }
            const float g1 = 1.0f / (1.0f + __expf(v0 - v1)), g0 = 1.0f - g1;
            if (lane == 0) { toke[2 * m] = e0; toke[2 * m + 1] = e1; tokg[2 * m] = g0; tokg[2 * m + 1] = g1; }
        }
    }
}

__device__ __forceinline__ void rope_sc(float posf, int i, int d, float& sn, float& cs) {
    const float invf = exp2f(-(float)i * (2.0f / (float)d) * LOG2_THETA); const float rev = posf * invf * INV_2PI; const float fr = rev - floorf(rev);
    sn = __builtin_amdgcn_sinf(fr); cs = __builtin_amdgcn_cosf(fr);
}
__device__ __forceinline__ void postproj_tokens(Ctx& C, const bf16* proj, const int* pos, const float* convw, const float* convb, const float* gq, const float* gk, const float* qan, const float* kvan,
                                                bf16* xc, bf16* qs, bf16* ks, bf16* qi, bf16* ki, bf16* cqn, bf16* ckvn) {
    const int gw = C.bid * 8 + C.wave, NGW = C.G * 8, lane = C.lane;
    const float QSCALE = 0.08838834764831845f;
    for (int m = gw; m < M; m += NGW) {
        const int t = m & (T - 1); const bf16* pr = proj + (size_t)m * PROJ_N; const float posf = (float)pos[m];
#pragma unroll
        for (int half = 0; half < 2; ++half) { const int c0 = half * 512 + lane * 8; float a[8];
#pragma unroll
            for (int i = 0; i < 8; ++i) a[i] = convb[c0 + i];
#pragma unroll
            for (int j = 0; j < 4; ++j) { if (t - 3 + j >= 0) { const u32x4 xv = *(const u32x4*)(pr - (ptrdiff_t)(3 - j) * PROJ_N + PX_LRUX + c0); const float* w = convw + j * 1024 + c0;
                a[0] += w[0] * bflo(xv.x); a[1] += w[1] * bfhi(xv.x); a[2] += w[2] * bflo(xv.y); a[3] += w[3] * bfhi(xv.y); a[4] += w[4] * bflo(xv.z); a[5] += w[5] * bfhi(xv.z); a[6] += w[6] * bflo(xv.w); a[7] += w[7] * bfhi(xv.w); } }
            u32x4 o; o.x = pk2(a[0], a[1]); o.y = pk2(a[2], a[3]); o.z = pk2(a[4], a[5]); o.w = pk2(a[6], a[7]); *(u32x4*)(xc + (size_t)m * 1024 + c0) = o; }
        { float sn, cs; rope_sc(posf, lane, 128, sn, cs);
#pragma unroll
          for (int h = 0; h < 8; ++h) {
#pragma unroll
            for (int which = 0; which < 2; ++which) { const int base = (which ? PX_AK : PX_AQ) + h * 128; const float* gg = which ? gk : gq;
                const float x1 = bf2f(pr[base + lane]), x2 = bf2f(pr[base + 64 + lane]); const float rstd = 1.0f / sqrtf(wave_sum(x1 * x1 + x2 * x2) * (1.0f / 128.0f) + EPS);
                const float y1 = x1 * rstd * gg[lane], y2 = x2 * rstd * gg[64 + lane]; const float sc = which ? 1.0f : QSCALE;
                bf16* o = (which ? ks : qs) + (size_t)m * 1024 + h * 128; o[lane] = f2bf((y1 * cs - y2 * sn) * sc); o[64 + lane] = f2bf((y2 * cs + y1 * sn) * sc); } } }
        { const int i = lane & 31; float sn, cs; rope_sc(posf, i, 64, sn, cs);
#pragma unroll
          for (int hh = 0; hh < 8; ++hh) { const int head = 2 * hh + (lane >> 5), base = PX_IQ + head * 64; const float x1 = bf2f(pr[base + i]), x2 = bf2f(pr[base + 32 + i]);
              bf16* o = qi + (size_t)m * 1024 + head * 64; o[i] = f2bf(x1 * cs - x2 * sn); o[32 + i] = f2bf(x2 * cs + x1 * sn); }
          if (lane < 32) { const float x1 = bf2f(pr[PX_IK + i]), x2 = bf2f(pr[PX_IK + 32 + i]); bf16* o = ki + (size_t)m * 64; o[i] = f2bf(x1 * cs - x2 * sn); o[32 + i] = f2bf(x2 * cs + x1 * sn); } }
        { float v[12]; float ss = 0.f;
#pragma unroll
          for (int j = 0; j < 12; ++j) { v[j] = bf2f(pr[PX_CQ + lane + 64 * j]); ss += v[j] * v[j]; }
          const float rstd = 1.0f / sqrtf(wave_sum(ss) * (1.0f / 768.0f) + EPS);
#pragma unroll
          for (int j = 0; j < 12; ++j) cqn[(size_t)m * 768 + lane + 64 * j] = f2bf(v[j] * rstd * qan[lane + 64 * j]); }
        { float v[8]; float ss = 0.f;
#pragma unroll
          for (int j = 0; j < 8; ++j) { v[j] = bf2f(pr[PX_CKV + lane + 64 * j]); ss += v[j] * v[j]; }
          const float rstd = 1.0f / sqrtf(wave_sum(ss) * (1.0f / 512.0f) + EPS);
#pragma unroll
          for (int j = 0; j < 8; ++j) ckvn[(size_t)m * 512 + lane + 64 * j] = f2bf(v[j] * rstd * kvan[lane + 64 * j]); }
    }
}
__device__ __forceinline__ void transpose_v(Ctx& C, const bf16* src, int pitch, int col0, int hstride, bf16* dst) {
    LAS bf16* tile = (LAS bf16*)C.lds;
    for (int u = C.bid; u < NB * 8 * 32; u += C.G) {
        const int tc = u & 31, h = (u >> 5) & 7, b = u >> 8;
        __syncthreads();
#pragma unroll
        for (int i = 0; i < 2; ++i) { const int idx = C.tid + i * 512, tl = idx >> 4, dc = idx & 15;
            const u32x4 v = *(const u32x4*)(src + (size_t)(b * T + tc * 64 + tl) * pitch + col0 + h * hstride + dc * 8); *(LAS u32x4*)(tile + tl * 136 + dc * 8) = v; }
        __syncthreads();
#pragma unroll
        for (int i = 0; i < 2; ++i) { const int idx = C.tid + i * 512, d = idx >> 3, t8 = idx & 7; const LAS bf16* s = tile + (t8 * 8) * 136 + d;
            u32x4 o; o.x = (unsigned)s[0] | ((unsigned)s[136] << 16); o.y = (unsigned)s[2 * 136] | ((unsigned)s[3 * 136] << 16); o.z = (unsigned)s[4 * 136] | ((unsigned)s[5 * 136] << 16); o.w = (unsigned)s[6 * 136] | ((unsigned)s[7 * 136] << 16);
#ifdef TV_SHORT_STORES
            { bf16* dp = dst + ((size_t)((b * 8 + h) * 128 + d)) * T + tc * 64 + t8 * 8; dp[0] = (bf16)(o.x & 0xffff); dp[1] = (bf16)(o.x >> 16); dp[2] = (bf16)(o.y & 0xffff); dp[3] = (bf16)(o.y >> 16); dp[4] = (bf16)(o.z & 0xffff); dp[5] = (bf16)(o.z >> 16); dp[6] = (bf16)(o.w & 0xffff); dp[7] = (bf16)(o.w >> 16); }
#else
            *(u32x4*)(dst + ((size_t)((b * 8 + h) * 128 + d)) * T + tc * 64 + t8 * 8) = o;
#endif
            }
    }
    __syncthreads();
}

__device__ __forceinline__ void topk_select(const LAS float* scw, int t, u64* maskrow, int lane) {
    u64 myword = 0;
    if (t + 1 <= 256) { int nv = t + 1 - 64 * lane; nv = nv < 0 ? 0 : (nv > 64 ? 64 : nv); myword = nv >= 64 ? ~0ull : ((1ull << nv) - 1ull); }
    else {
        unsigned u[32];
#pragma unroll
        for (int jj = 0; jj < 32; ++jj) { const unsigned bits = __builtin_bit_cast(unsigned, scw[jj * 64 + lane]); const unsigned uu = (bits & 0x80000000u) ? ~bits : (bits | 0x80000000u); u[jj] = (jj * 64 + lane <= t) ? uu : 0u; }
        unsigned tau = 0u;
        const int njj = (t >> 6) + 1;
        for (int bit = 31; bit >= 0; --bit) { const unsigned cand = tau | (1u << bit); int c = 0;
#pragma unroll
            for (int jj = 0; jj < 8; ++jj) c += (u[jj] >= cand) ? 1 : 0;
            if (njj > 8) {
#pragma unroll
                for (int jj = 8; jj < 16; ++jj) c += (u[jj] >= cand) ? 1 : 0; }
            if (njj > 16) {
#pragma unroll
                for (int jj = 16; jj < 24; ++jj) c += (u[jj] >= cand) ? 1 : 0; }
            if (njj > 24) {
#pragma unroll
                for (int jj = 24; jj < 32; ++jj) c += (u[jj] >= cand) ? 1 : 0; }
            const int cnt = wave_sum_i(c);
            if (cnt >= 256) { tau = cand; if (cnt == 256) break; } }
        int cg = 0;
#pragma unroll
        for (int jj = 0; jj < 32; ++jj) cg += (u[jj] > tau) ? 1 : 0;
        int need = 256 - wave_sum_i(cg);
#pragma unroll
        for (int jj = 0; jj < 32; ++jj) { u64 g = __ballot(u[jj] > tau); const u64 e = __ballot(u[jj] == tau);
            if (need > 0 && e != 0ull) { const int c = __popcll(e);
                if (c <= need) { g |= e; need -= c; }
                else { u64 keep = 0ull, ee = e; for (int q = 0; q < need; ++q) { keep |= ee & (0ull - ee); ee &= ee - 1ull; } g |= keep; need = 0; } }
            if (lane == jj) myword = g; }
    }
    if (lane < 32) maskrow[lane] = myword;
}
__device__ __forceinline__ void indexer_naive(Ctx& C, const bf16* proj, const bf16* qi, const bf16* ki, u64* sel) {
    LAS float* qf = (LAS float*)(C.lds + C.wave * 16384); LAS float* scw = qf + 1024;
    const int gw = C.bid * 8 + C.wave, NGW = C.G * 8, lane = C.lane;
    for (int m = gw; m < M; m += NGW) {
        const int b = m >> 11, t = m & (T - 1);
        if (t + 1 > 256) {
            { const u32x4 a = *(const u32x4*)(qi + (size_t)m * 1024 + lane * 16), c = *(const u32x4*)(qi + (size_t)m * 1024 + lane * 16 + 8); LAS float* o = qf + lane * 16;
              o[0] = bflo(a.x); o[1] = bfhi(a.x); o[2] = bflo(a.y); o[3] = bfhi(a.y); o[4] = bflo(a.z); o[5] = bfhi(a.z); o[6] = bflo(a.w); o[7] = bfhi(a.w);
              o[8] = bflo(c.x); o[9] = bfhi(c.x); o[10] = bflo(c.y); o[11] = bfhi(c.y); o[12] = bflo(c.z); o[13] = bfhi(c.z); o[14] = bflo(c.w); o[15] = bfhi(c.w); }
            const float iwv = lane < 16 ? bf2f(proj[(size_t)m * PROJ_N + PX_IW + lane]) : 0.f;
            asm volatile("s_waitcnt lgkmcnt(0)" ::: "memory");
#pragma nounroll
            for (int jj = 0; jj < 32; ++jj) {
                if (jj * 64 > t) { scw[jj * 64 + lane] = -INFINITY; continue; }
                const int key = jj * 64 + lane; const u32x4* kp = (const u32x4*)(ki + (size_t)(b * T + key) * 64); float kf[64];
#pragma unroll
                for (int c8 = 0; c8 < 8; ++c8) { const u32x4 kv = kp[c8]; kf[c8 * 8 + 0] = bflo(kv.x); kf[c8 * 8 + 1] = bfhi(kv.x); kf[c8 * 8 + 2] = bflo(kv.y); kf[c8 * 8 + 3] = bfhi(kv.y); kf[c8 * 8 + 4] = bflo(kv.z); kf[c8 * 8 + 5] = bfhi(kv.z); kf[c8 * 8 + 6] = bflo(kv.w); kf[c8 * 8 + 7] = bfhi(kv.w); }
                float s = 0.f;
#pragma nounroll
                for (int h = 0; h < 16; ++h) { const float wh = rd_lane(iwv, h); float d = 0.f;
#pragma unroll
                    for (int i4 = 0; i4 < 16; ++i4) { const f32x4 q4 = *(const LAS f32x4*)(qf + h * 64 + i4 * 4); d += q4[0] * kf[i4 * 4] + q4[1] * kf[i4 * 4 + 1] + q4[2] * kf[i4 * 4 + 2] + q4[3] * kf[i4 * 4 + 3]; }
                    s += wh * fmaxf(d, 0.f); }
                scw[key] = (key <= t) ? s : -INFINITY;
            }
            asm volatile("s_waitcnt lgkmcnt(0)" ::: "memory");
        }
        topk_select(scw, t, sel + (size_t)m * 32, lane);
    }
}

__device__ __forceinline__ void sparse_attn_naive(Ctx& C, const bf16* proj, const bf16* qs, const bf16* ks, const u64* sel, bf16* outb) {
    LAS float* qf = (LAS float*)(C.lds + C.wave * 16384); LAS float* scw = qf + 256;
    const int gw = C.bid * 8 + C.wave, NGW = C.G * 8, lane = C.lane;
    for (int m = gw; m < M; m += NGW) {
        const int b = m >> 11;
        unsigned wlo = 0u, whi = 0u; if (lane < 32) { const u64 w = sel[(size_t)m * 32 + lane]; wlo = (unsigned)w; whi = (unsigned)(w >> 32); }
        for (int h = 0; h < 8; ++h) {
            qf[lane] = bf2f(qs[(size_t)m * 1024 + h * 128 + lane]); qf[64 + lane] = bf2f(qs[(size_t)m * 1024 + h * 128 + 64 + lane]);
            asm volatile("s_waitcnt lgkmcnt(0)" ::: "memory");
            float mx = -INFINITY;
            for (int jj = 0; jj < 32; ++jj) { const u64 w = ((u64)rd_lane_u(whi, jj) << 32) | (u64)rd_lane_u(wlo, jj); if (w == 0ull) continue;
                float s = -INFINITY;
                if ((w >> lane) & 1ull) { const u32x4* kp = (const u32x4*)(ks + (size_t)(b * T + jj * 64 + lane) * 1024 + h * 128); float d = 0.f;
#pragma unroll
                    for (int c8 = 0; c8 < 16; ++c8) { const u32x4 kv = kp[c8]; const f32x4 q0 = *(const LAS f32x4*)(qf + c8 * 8), q1 = *(const LAS f32x4*)(qf + c8 * 8 + 4);
                        d += q0[0] * bflo(kv.x) + q0[1] * bfhi(kv.x) + q0[2] * bflo(kv.y) + q0[3] * bfhi(kv.y) + q1[0] * bflo(kv.z) + q1[1] * bfhi(kv.z) + q1[2] * bflo(kv.w) + q1[3] * bfhi(kv.w); }
                    s = d; }
                scw[jj * 64 + lane] = s; mx = fmaxf(mx, s); }
            mx = wave_max(mx);
            float sum = 0.f;
            for (int jj = 0; jj < 32; ++jj) { const u64 w = ((u64)rd_lane_u(whi, jj) << 32) | (u64)rd_lane_u(wlo, jj); if (w == 0ull) continue;
                const float s = scw[jj * 64 + lane]; const float p = ((w >> lane) & 1ull) ? __expf(s - mx) : 0.f; scw[jj * 64 + lane] = p; sum += p; }
            sum = wave_sum(sum);
            asm volatile("s_waitcnt lgkmcnt(0)" ::: "memory");
            float a0 = 0.f, a1 = 0.f;
            for (int jj = 0; jj < 32; ++jj) { u64 w = ((u64)rd_lane_u(whi, jj) << 32) | (u64)rd_lane_u(wlo, jj);
                while (w) { const int bit = __builtin_ctzll(w); w &= w - 1ull; const float p = scw[jj * 64 + bit]; const bf16* vp = proj + (size_t)(b * T + jj * 64 + bit) * PROJ_N + PX_AV + h * 128;
                    a0 += p * bf2f(vp[lane]); a1 += p * bf2f(vp[64 + lane]); } }
            const float inv = 1.0f / sum; outb[(size_t)m * 1024 + h * 128 + lane] = f2bf(a0 * inv); outb[(size_t)m * 1024 + h * 128 + 64 + lane] = f2bf(a1 * inv);
        }
    }
}
__device__ __forceinline__ void mla_attn_naive(Ctx& C, const bf16* qm, const bf16* km, const bf16* kvmr, bf16* outc) {
    LAS float* qf = (LAS float*)(C.lds + C.wave * 16384); LAS float* scw = qf + 256;
    const int gw = C.bid * 8 + C.wave, NGW = C.G * 8, lane = C.lane;
    for (int m = gw; m < M; m += NGW) {
        const int b = m >> 11, t = m & (T - 1), njj = (t >> 6) + 1;
        for (int h = 0; h < 8; ++h) {
            qf[lane] = bf2f(qm[(size_t)m * 1536 + h * 192 + lane]); qf[64 + lane] = bf2f(qm[(size_t)m * 1536 + h * 192 + 64 + lane]); qf[128 + lane] = bf2f(qm[(size_t)m * 1536 + h * 192 + 128 + lane]);
            asm volatile("s_waitcnt lgkmcnt(0)" ::: "memory");
            float mx = -INFINITY;
            for (int jj = 0; jj < njj; ++jj) { const int key = jj * 64 + lane; float s = -INFINITY;
                if (key <= t) { const u32x4* kp = (const u32x4*)(km + (size_t)(b * T + key) * 1536 + h * 192); float d = 0.f;
#pragma unroll
                    for (int c8 = 0; c8 < 24; ++c8) { const u32x4 kv = kp[c8]; const f32x4 q0 = *(const LAS f32x4*)(qf + c8 * 8), q1 = *(const LAS f32x4*)(qf + c8 * 8 + 4);
                        d += q0[0] * bflo(kv.x) + q0[1] * bfhi(kv.x) + q0[2] * bflo(kv.y) + q0[3] * bfhi(kv.y) + q1[0] * bflo(kv.z) + q1[1] * bfhi(kv.z) + q1[2] * bflo(kv.w) + q1[3] * bfhi(kv.w); }
                    s = d; }
                scw[key] = s; mx = fmaxf(mx, s); }
            mx = wave_max(mx);
            float sum = 0.f;
            for (int jj = 0; jj < njj; ++jj) { const int key = jj * 64 + lane; const float s = scw[key]; const float p = (key <= t) ? __expf(s - mx) : 0.f; scw[key] = p; sum += p; }
            sum = wave_sum(sum);
            asm volatile("s_waitcnt lgkmcnt(0)" ::: "memory");
            float a0 = 0.f, a1 = 0.f;
            for (int key = 0; key <= t; ++key) { const float p = scw[key]; const bf16* vp = kvmr + (size_t)(b * T + key) * 2048 + h * 256 + 128; a0 += p * bf2f(vp[lane]); a1 += p * bf2f(vp[64 + lane]); }
            const float inv = 1.0f / sum; outc[(size_t)m * 1024 + h * 128 + lane] = f2bf(a0 * inv); outc[(size_t)m * 1024 + h * 128 + 64 + lane] = f2bf(a1 * inv);
        }
    }
}

template <int DQK, bool SPARSE>
__device__ __forceinline__ void attn_mfma(Ctx& C, const bf16* __restrict__ Q, const bf16* __restrict__ K, const bf16* __restrict__ Vt, const u64* __restrict__ sel, bf16* __restrict__ O) {
    constexpr int NC = DQK / 32, NCB = DQK / 64, KTB = NCB * 8192, VTB = 2 * 8192, NP = NCB + 2 + (SPARSE ? 1 : 0);
    constexpr int MOFF = 3 * KTB + 3 * VTB, MSB = 8 * 256;
    static_assert(MOFF + 3 * MSB <= LDS_RING, "attention LDS");
    constexpr float LOG2E = 1.4426950408889634f;
    const int lane = C.lane, wave = C.wave, r = lane & 15, g = lane >> 4;
    LAS unsigned char* const lds = C.lds;
    const unsigned ldsw = (unsigned)(size_t)lds + (unsigned)(wave * 1024);
    const unsigned ldsm = (unsigned)(size_t)lds + (unsigned)(MOFF + wave * 256);
    const int sb = lane * 16, swz = sb ^ (((sb >> 9) & 1) << 5), srow = 16 * (wave >> 1) + (swz >> 6), scol = 32 * (wave & 1) + ((swz & 63) >> 1);
    const unsigned koff = (unsigned)(srow * 8 * DQK * 2 + scol * 2);
    const unsigned voff = (unsigned)(srow * T * 2 + scol * 2);
    const int rk = (r * 64 + g * 16) ^ ((r >> 3) << 5);
    const int rv0 = (r * 64 + g * 8) ^ ((r >> 3) << 5), rv1 = rv0 ^ 32;
#define ATT_WAIT(n_) asm volatile("s_waitcnt vmcnt(" #n_ ")" ::: "memory")
    for (int unit = C.bid; unit < 256; unit += C.G) {
        const int pbh = (unit & 7) + 8 * (unit >> 6), b = pbh >> 3, h = pbh & 7, x = (unit >> 3) & 7;
        const int qblk = (wave >> 2) ? (15 - x) : x, q0 = qblk * 128 + (wave & 3) * 32;
        const int nkt = 2 * (16 - x), my_last = (q0 + 31) >> 6;
        bf16x8 qf[2][NC];
#pragma unroll
        for (int mt = 0; mt < 2; ++mt)
#pragma unroll
            for (int c = 0; c < NC; ++c) qf[mt][c] = *(const bf16x8*)(Q + ((size_t)(b * T + q0 + 16 * mt + r) * 8 + h) * DQK + 32 * c + 8 * g);
        f32x4 Oa[2][8];
#pragma unroll
        for (int mt = 0; mt < 2; ++mt)
#pragma unroll
            for (int n = 0; n < 8; ++n) Oa[mt][n] = (f32x4){0.f, 0.f, 0.f, 0.f};
        float mrun[2] = {-INFINITY, -INFINITY}, lrun[2] = {0.f, 0.f};
        const char* Kb = (const char*)(K + ((size_t)(b * T) * 8 + h) * DQK); const char* Vb = (const char*)(Vt + (size_t)((b * 8 + h) * 128) * T);
        const char* selb = SPARSE ? (const char*)(sel + (size_t)(b * T + q0 + (lane >> 1)) * 32) + (lane & 1) * 4 : nullptr;
#define ATT_DMA(gp_, la_) asm volatile("s_mov_b32 m0, %0\n\ts_nop 0\n\tglobal_load_lds_dwordx4 %1, off" :: "s"(la_), "v"(gp_) : "memory", "m0")
#define ATT_LOAD(kt_, buf_) do { const unsigned lb_ = __builtin_amdgcn_readfirstlane(ldsw + (unsigned)((buf_) * KTB)), lv_ = __builtin_amdgcn_readfirstlane(ldsw + (unsigned)(3 * KTB + (buf_) * VTB)); \
        _Pragma("unroll") for (int cb_ = 0; cb_ < NCB; ++cb_) ATT_DMA(Kb + (size_t)(kt_) * (64 * 8 * DQK * 2) + koff + cb_ * 128, lb_ + cb_ * 8192); \
        _Pragma("unroll") for (int rb_ = 0; rb_ < 2; ++rb_) ATT_DMA(Vb + (size_t)(kt_) * 128 + voff + rb_ * (64 * T * 2), lv_ + rb_ * 8192); \
        if (SPARSE) { const unsigned lm_ = __builtin_amdgcn_readfirstlane(ldsm + (unsigned)((buf_) * MSB)); \
            asm volatile("s_mov_b32 m0, %0\n\ts_nop 0\n\tglobal_load_lds_dword %1, off" :: "s"(lm_), "v"(selb + (size_t)(kt_) * 8) : "memory", "m0"); } } while (0)
        __builtin_amdgcn_s_waitcnt(0x0070); asm volatile("" ::: "memory"); __builtin_amdgcn_s_barrier();
        ATT_LOAD(0, 0);
        if (nkt > 1) ATT_LOAD(1, 1);
        ATT_WAIT(0);
        __builtin_amdgcn_s_barrier();
        int cb = 0;
        for (int kt = 0; kt < nkt; ++kt) {
            const bool more2 = kt + 2 < nkt; const int nb2 = (cb == 0) ? 2 : cb - 1;
            if (more2) ATT_LOAD(kt + 2, nb2);
            if (kt <= my_last) {
                const LAS unsigned char* kb = lds + cb * KTB + rk; const LAS unsigned char* vb = lds + 3 * KTB + cb * VTB;
                f32x4 S[2][4];
#pragma unroll
                for (int mt = 0; mt < 2; ++mt)
#pragma unroll
                    for (int s4 = 0; s4 < 4; ++s4) S[mt][s4] = (f32x4){0.f, 0.f, 0.f, 0.f};
#define KFRAG(i_) (*(const LAS bf16x8*)(kb + (((i_) >> 2) >> 1) * 8192 + (((i_) & 3) * 2 + (((i_) >> 2) & 1)) * 1024))
#define VFRAG(j_, dst_) do { const LAS unsigned char* vp_ = vb + (((j_) & 7) >> 2) * 8192 + ((((j_) & 7) & 3) * 2 + ((j_) >> 3)) * 1024; const u32x2 v0_ = *(const LAS u32x2*)(vp_ + rv0), v1_ = *(const LAS u32x2*)(vp_ + rv1); \
                    u32x4 w_; w_.x = v0_.x; w_.y = v0_.y; w_.z = v1_.x; w_.w = v1_.y; dst_ = __builtin_bit_cast(bf16x8, w_); } while (0)
                constexpr int PD = 4, RG = PD + 1, NS = 4 * NC;
                bf16x8 kr[RG];
#pragma unroll
                for (int i = 0; i < PD; ++i) kr[i] = KFRAG(i);
                __builtin_amdgcn_sched_barrier(0);
#pragma unroll
                for (int i = 0; i < NS; ++i) { const int c = i >> 2, s4 = i & 3;
                    if (i + PD < NS) kr[(i + PD) % RG] = KFRAG(i + PD);
                    S[0][s4] = __builtin_amdgcn_mfma_f32_16x16x32_bf16(kr[i % RG], qf[0][c], S[0][s4], 0, 0, 0); S[1][s4] = __builtin_amdgcn_mfma_f32_16x16x32_bf16(kr[i % RG], qf[1][c], S[1][s4], 0, 0, 0);
                    __builtin_amdgcn_sched_barrier(0); }
                bf16x8 vr[RG];
#pragma unroll
                for (int j = 0; j < PD; ++j) VFRAG(j, vr[j]);
                __builtin_amdgcn_sched_barrier(0);
                bf16x8 pf[2][2];
                const bool diag = (64 * kt + 63 > q0);
                u32x2 wsel[2] = {(u32x2){0u, 0u}, (u32x2){0u, 0u}};
                if (SPARSE) { const LAS unsigned char* mb = lds + MOFF + cb * MSB + wave * 256 + r * 8; wsel[0] = *(const LAS u32x2*)mb; wsel[1] = *(const LAS u32x2*)(mb + 128); }
#pragma unroll
                for (int mt = 0; mt < 2; ++mt) {
                    const int qrow = q0 + 16 * mt + r; float mx = -INFINITY;
                    if (SPARSE || diag) {
#pragma unroll
                        for (int s4 = 0; s4 < 4; ++s4) {
                            unsigned nib = 0u; if (SPARSE) { const unsigned hw_ = (s4 < 2) ? wsel[mt].x : wsel[mt].y; nib = (hw_ >> (16 * (s4 & 1) + 4 * g)) & 15u; }
#pragma unroll
                            for (int i = 0; i < 4; ++i) { bool ok;
                                if (SPARSE) ok = (nib >> i) & 1u; else ok = (64 * kt + 16 * s4 + 4 * g + i <= qrow);
                                S[mt][s4][i] = ok ? S[mt][s4][i] : -INFINITY; } } }
#pragma unroll
                    for (int s4 = 0; s4 < 4; ++s4)
#pragma unroll
                        for (int i = 0; i < 4; ++i) mx = fmaxf(mx, S[mt][s4][i]);
                    mx = fmaxf(mx, __shfl_xor(mx, 16)); mx = fmaxf(mx, __shfl_xor(mx, 32));
                    const float mnew = fmaxf(mrun[mt], mx), msafe = (mnew == -INFINITY) ? 0.f : mnew, ml = msafe * LOG2E;
                    const float alpha = __builtin_amdgcn_exp2f((mrun[mt] - msafe) * LOG2E); mrun[mt] = mnew;
                    float ps = 0.f;
#pragma unroll
                    for (int s4 = 0; s4 < 4; ++s4)
#pragma unroll
                        for (int i = 0; i < 4; ++i) { const float p = __builtin_amdgcn_exp2f(S[mt][s4][i] * LOG2E - ml); S[mt][s4][i] = p; ps += p; }
                    lrun[mt] = lrun[mt] * alpha + ps;
                    if (__builtin_amdgcn_ballot_w64(alpha != 1.0f)) {
#pragma unroll
                        for (int n = 0; n < 8; ++n) Oa[mt][n] = Oa[mt][n] * alpha; }
#pragma unroll
                    for (int c = 0; c < 2; ++c) { u32x4 w; w.x = pk2(S[mt][2 * c][0], S[mt][2 * c][1]); w.y = pk2(S[mt][2 * c][2], S[mt][2 * c][3]); w.z = pk2(S[mt][2 * c + 1][0], S[mt][2 * c + 1][1]); w.w = pk2(S[mt][2 * c + 1][2], S[mt][2 * c + 1][3]);
                        pf[mt][c] = __builtin_bit_cast(bf16x8, w); }
                }
                __builtin_amdgcn_sched_barrier(0);
#pragma unroll
                for (int j = 0; j < 16; ++j) { const int c = j >> 3, n = j & 7;
                    if (j + PD < 16) VFRAG(j + PD, vr[(j + PD) % RG]);
                    Oa[0][n] = __builtin_amdgcn_mfma_f32_16x16x32_bf16(vr[j % RG], pf[0][c], Oa[0][n], 0, 0, 0); Oa[1][n] = __builtin_amdgcn_mfma_f32_16x16x32_bf16(vr[j % RG], pf[1][c], Oa[1][n], 0, 0, 0);
                    __builtin_amdgcn_sched_barrier(0); }
#undef KFRAG
#undef VFRAG
            }
            if (more2) asm volatile("s_waitcnt vmcnt(%0)" :: "n"(NP) : "memory"); else ATT_WAIT(0);
            asm volatile("s_waitcnt lgkmcnt(0)" ::: "memory"); __builtin_amdgcn_s_barrier();
            cb = (cb == 2) ? 0 : cb + 1;
        }
#pragma unroll
        for (int mt = 0; mt < 2; ++mt) { float l = lrun[mt]; l += __shfl_xor(l, 16); l += __shfl_xor(l, 32); const float inv = 1.0f / l;
            bf16* op = O + (size_t)(b * T + q0 + 16 * mt + r) * 1024 + h * 128 + 4 * g;
#pragma unroll
            for (int n = 0; n < 8; ++n) { const f32x4 o = Oa[mt][n] * inv; u32x2 w; w.x = pk2(o[0], o[1]); w.y = pk2(o[2], o[3]); *(u32x2*)(op + 16 * n) = w; } }
#undef ATT_LOAD
#undef ATT_DMA
    }
#undef ATT_WAIT
    __syncthreads();
}

__device__ __forceinline__ void indexer_mfma(Ctx& C, const bf16* proj, const bf16* qi, const bf16* ki, u64* sel) {
    LAS float* scw = (LAS float*)(C.lds + C.wave * 16384);
    const int gw = C.bid * 8 + C.wave, NGW = C.G * 8, lane = C.lane, r = lane & 15, g = lane >> 4;
    for (int P = gw, it = 0; P < M / 2; P += NGW, ++it) {
        const int b = P >> 10, pp = P & 1023, t0 = (it & 1) ? (2046 - 2 * pp) : (2 * pp), m0 = b * T + t0;
        if (t0 + 2 > 256) {
            bf16x8 a0[2], a1[2]; float w0[2], w1[2], w2[2], w3[2];
#pragma unroll
            for (int q = 0; q < 2; ++q) { a0[q] = *(const bf16x8*)(qi + (size_t)(m0 + q) * 1024 + r * 64 + 8 * g); a1[q] = *(const bf16x8*)(qi + (size_t)(m0 + q) * 1024 + r * 64 + 32 + 8 * g);
                const u32x2 ww = *(const u32x2*)(proj + (size_t)(m0 + q) * PROJ_N + PX_IW + 4 * g); w0[q] = bflo(ww.x); w1[q] = bfhi(ww.x); w2[q] = bflo(ww.y); w3[q] = bfhi(ww.y); }
            const int njj = ((t0 + 1) >> 6) + 1;
            const bf16* kp = ki + (size_t)(b * T + r) * 64 + 8 * g; bf16x8 kb[4][2], kn[4][2];
#pragma unroll
            for (int s4 = 0; s4 < 4; ++s4) { kb[s4][0] = *(const bf16x8*)(kp + s4 * 16 * 64); kb[s4][1] = *(const bf16x8*)(kp + s4 * 16 * 64 + 32); }
#pragma nounroll
            for (int jj = 0; jj < njj; ++jj) {
                const bf16* kq = kp + (size_t)((jj + 1 < njj) ? (jj + 1) : jj) * 64 * 64;
#pragma unroll
                for (int s4 = 0; s4 < 4; ++s4) { kn[s4][0] = *(const bf16x8*)(kq + s4 * 16 * 64); kn[s4][1] = *(const bf16x8*)(kq + s4 * 16 * 64 + 32); }
                float val[2] = {0.f, 0.f};
#pragma unroll
                for (int s4 = 0; s4 < 4; ++s4)
#pragma unroll
                    for (int q = 0; q < 2; ++q) { f32x4 d = (f32x4){0.f, 0.f, 0.f, 0.f};
                        d = __builtin_amdgcn_mfma_f32_16x16x32_bf16(a0[q], kb[s4][0], d, 0, 0, 0); d = __builtin_amdgcn_mfma_f32_16x16x32_bf16(a1[q], kb[s4][1], d, 0, 0, 0);
                        float part = w0[q] * relu_(d[0]) + w1[q] * relu_(d[1]) + w2[q] * relu_(d[2]) + w3[q] * relu_(d[3]);
                        part += __shfl_xor(part, 16); part += __shfl_xor(part, 32);
                        val[q] = (g == s4) ? part : val[q]; }
                scw[jj * 64 + lane] = val[0]; scw[2048 + jj * 64 + lane] = val[1];
#pragma unroll
                for (int s4 = 0; s4 < 4; ++s4) { kb[s4][0] = kn[s4][0]; kb[s4][1] = kn[s4][1]; }
            }
            asm volatile("s_waitcnt lgkmcnt(0)" ::: "memory");
        }
        topk_select(scw, t0, sel + (size_t)m0 * 32, lane);
        topk_select(scw + 2048, t0 + 1, sel + (size_t)(m0 + 1) * 32, lane);
    }
}

__device__ __forceinline__ void lru_scan(Ctx& C, const bf16* la, const bf16* lb, const bf16* proj, bf16* outa) {
    LAS float* cA = (LAS float*)C.lds; LAS float* cB = cA + 512;
    for (int u = C.bid; u < 256; u += C.G) {
        const int b = u >> 6, cg = u & 63, cl = C.tid & 15, chunk = C.tid >> 4, ch = cg * 16 + cl;
        const size_t base = (size_t)(b * T + chunk * 64) * 1024 + ch;
        float A = 1.f, Bv = 0.f;
        unsigned pk[64];
#pragma unroll
        for (int s = 0; s < 64; ++s) pk[s] = (unsigned)__builtin_bit_cast(unsigned short, la[base + (size_t)s * 1024]) | ((unsigned)__builtin_bit_cast(unsigned short, lb[base + (size_t)s * 1024]) << 16);
#pragma unroll
        for (int s = 0; s < 64; ++s) { const float a = 1.0f - bflo(pk[s]), bb = bfhi(pk[s]); Bv = a * Bv + bb; A *= a; }
        __syncthreads();
        cA[chunk * 16 + cl] = A; cB[chunk * 16 + cl] = Bv;
        __syncthreads();
        float H = 0.f;
        for (int j = 0; j < chunk; ++j) H = cA[j * 16 + cl] * H + cB[j * 16 + cl];
#pragma unroll
        for (int s = 0; s < 64; ++s) { const float a = 1.0f - bflo(pk[s]), bb = bfhi(pk[s]); H = a * H + bb;
            const size_t m = (size_t)(b * T + chunk * 64 + s); const float g = bf2f(proj[m * PROJ_N + PX_LRUG + ch]); outa[m * 1024 + ch] = f2bf(H * gelu_tanh(g)); }
    }
    __syncthreads();
}

__device__ __forceinline__ void mla_post(Ctx& C, const bf16* proj, const int* pos, const bf16* qmr, const bf16* kvmr, const float* qn, const float* kn, bf16* qm, bf16* km) {
    const int gw = C.bid * 8 + C.wave, NGW = C.G * 8, lane = C.lane, i = lane & 31;
    const float QMSCALE = 0.07216878364870323f;
    for (int m = gw; m < M; m += NGW) {
        float sn, cs; rope_sc((float)pos[m], i, 64, sn, cs);
        const float kr1 = bf2f(proj[(size_t)m * PROJ_N + PX_KR + i]), kr2 = bf2f(proj[(size_t)m * PROJ_N + PX_KR + 32 + i]);
#pragma unroll
        for (int h = 0; h < 8; ++h) {
            { const bf16* q = qmr + (size_t)m * 1536 + h * 192; const float x0 = bf2f(q[lane]), x1 = bf2f(q[64 + lane]), r1 = bf2f(q[128 + i]), r2 = bf2f(q[160 + i]);
              const float ss = wave_sum(x0 * x0 + x1 * x1 + (lane < 32 ? r1 * r1 + r2 * r2 : 0.f)); const float rstd = 1.0f / sqrtf(ss * (1.0f / 192.0f) + EPS) * QMSCALE;
              bf16* o = qm + (size_t)m * 1536 + h * 192; o[lane] = f2bf(x0 * rstd * qn[lane]); o[64 + lane] = f2bf(x1 * rstd * qn[64 + lane]);
              const float z1 = r1 * rstd * qn[128 + i], z2 = r2 * rstd * qn[160 + i]; if (lane < 32) { o[128 + i] = f2bf(z1 * cs - z2 * sn); o[160 + i] = f2bf(z2 * cs + z1 * sn); } }
            { const bf16* k = kvmr + (size_t)m * 2048 + h * 256; const float x0 = bf2f(k[lane]), x1 = bf2f(k[64 + lane]);
              const float ss = wave_sum(x0 * x0 + x1 * x1 + (lane < 32 ? kr1 * kr1 + kr2 * kr2 : 0.f)); const float rstd = 1.0f / sqrtf(ss * (1.0f / 192.0f) + EPS);
              bf16* o = km + (size_t)m * 1536 + h * 192; o[lane] = f2bf(x0 * rstd * kn[lane]); o[64 + lane] = f2bf(x1 * rstd * kn[64 + lane]);
              const float z1 = kr1 * rstd * kn[128 + i], z2 = kr2 * rstd * kn[160 + i]; if (lane < 32) { o[128 + i] = f2bf(z1 * cs - z2 * sn); o[160 + i] = f2bf(z2 * cs + z1 * sn); } }
        }
    }
}

__device__ __forceinline__ void moe_route(Ctx& C, int* mi) {
    if (C.bid != 0) return;
    LAS int* hist = (LAS int*)C.lds;
    LAS int* tot = hist + 8 * 512;
    const int* toke = mi + MI_TOKE; const float* tokg = (const float*)(mi + MI_TOKG); int* dest = mi + MI_DEST; int* rowtok = mi + MI_ROWTOK; float* rowg = (float*)(mi + MI_ROWG); int* blke = mi + MI_BLKE;
    const int tid = C.tid, lane = C.lane;
    for (int i = tid; i < MOE_ROWS; i += 512) { rowtok[i] = M; rowg[i] = 0.f; }
    int cnt[8];
#pragma unroll
    for (int e = 0; e < 8; ++e) cnt[e] = 0;
    for (int j = 0; j < 32; ++j) { const int ee = toke[tid * 32 + j];
#pragma unroll
        for (int e = 0; e < 8; ++e) cnt[e] += (ee == e) ? 1 : 0; }
#pragma unroll
    for (int e = 0; e < 8; ++e) hist[e * 512 + tid] = cnt[e];
    __syncthreads();
    { const int e = C.wave; int v[8]; int s = 0;
#pragma unroll
      for (int j = 0; j < 8; ++j) { v[j] = hist[e * 512 + lane * 8 + j]; s += v[j]; }
      int incl = s;
#pragma unroll
      for (int o = 1; o < 64; o <<= 1) { const int y = __shfl_up(incl, o); if (lane >= o) incl += y; }
      int run = incl - s;
#pragma unroll
      for (int j = 0; j < 8; ++j) { hist[e * 512 + lane * 8 + j] = run; run += v[j]; }
      if (lane == 63) tot[e] = incl; }
    __syncthreads();
    int base[8]; int ps = 0; int pend[8];
#pragma unroll
    for (int e = 0; e < 8; ++e) { const int pad = (tot[e] + 255) / 256 * 256; base[e] = ps + hist[e * 512 + tid]; ps += pad; pend[e] = ps; }
    for (int j = 0; j < 32; ++j) { const int a = tid * 32 + j; const int ee = toke[a]; int d = 0;
#pragma unroll
        for (int e = 0; e < 8; ++e) if (ee == e) { d = base[e]; base[e] += 1; }
        dest[a] = d; rowtok[d] = a >> 1; rowg[d] = tokg[a]; }
    if (tid < MOE_BLKS) { int e = 0;
#pragma unroll
        for (int q = 0; q < 8; ++q) e += (pend[q] <= tid * 256) ? 1 : 0;
        blke[tid] = e > 7 ? 7 : e; }
    if (tid == 0) { mi[MI_NUSED] = ps / 256; mi[MI_BSTART] = 0; }
    if (tid < 8) { int pe = 0;
#pragma unroll
        for (int q = 0; q < 8; ++q) pe = (tid == q) ? pend[q] : pe;
        mi[MI_BSTART + 1 + tid] = pe / 256; }
    __syncthreads();
}
__device__ __forceinline__ void moe_gather_fp8(Ctx& C, const int* mi, const bf16* hn, unsigned char* xs) {
    const int gw = C.bid * 8 + C.wave, NGW = C.G * 8, lane = C.lane; const int nrows = mi[MI_NUSED] * 256; const int* rowtok = mi + MI_ROWTOK;
    for (int r = gw; r < nrows; r += NGW) { const int tok = rowtok[r]; u32x4* o = (u32x4*)(xs + (size_t)r * D + lane * 32);
        if (tok < M) { const u32x4* sp = (const u32x4*)(hn + (size_t)tok * D + lane * 32); u32x4 ov[2];
#pragma unroll
            for (int h2 = 0; h2 < 2; ++h2) { const u32x4 a = sp[2 * h2], b = sp[2 * h2 + 1];
                ov[h2].x = pk4_fp8(bflo(a.x) * F8_XSCALE, bfhi(a.x) * F8_XSCALE, bflo(a.y) * F8_XSCALE, bfhi(a.y) * F8_XSCALE); ov[h2].y = pk4_fp8(bflo(a.z) * F8_XSCALE, bfhi(a.z) * F8_XSCALE, bflo(a.w) * F8_XSCALE, bfhi(a.w) * F8_XSCALE);
                ov[h2].z = pk4_fp8(bflo(b.x) * F8_XSCALE, bfhi(b.x) * F8_XSCALE, bflo(b.y) * F8_XSCALE, bfhi(b.y) * F8_XSCALE); ov[h2].w = pk4_fp8(bflo(b.z) * F8_XSCALE, bfhi(b.z) * F8_XSCALE, bflo(b.w) * F8_XSCALE, bfhi(b.w) * F8_XSCALE); }
            o[0] = ov[0]; o[1] = ov[1]; }
        else { o[0] = (u32x4){0u, 0u, 0u, 0u}; o[1] = (u32x4){0u, 0u, 0u, 0u}; } }
}
__device__ __forceinline__ void moe_gather(Ctx& C, const int* mi, const bf16* hn, bf16* xs) {
    const int gw = C.bid * 8 + C.wave, NGW = C.G * 8, lane = C.lane; const int nrows = mi[MI_NUSED] * 256; const int* rowtok = mi + MI_ROWTOK;
    for (int r = gw; r < nrows; r += NGW) { const int tok = rowtok[r]; u32x4* o = (u32x4*)(xs + (size_t)r * D) + lane;
        if (tok < M) { const u32x4* s = (const u32x4*)(hn + (size_t)tok * D) + lane;
#pragma unroll
            for (int j = 0; j < 4; ++j) o[64 * j] = s[64 * j]; }
        else {
#pragma unroll
            for (int j = 0; j < 4; ++j) o[64 * j] = (u32x4){0u, 0u, 0u, 0u}; } }
}
__device__ __forceinline__ void moe_combine(Ctx& C, const int* mi, const bf16* ys, bf16* h) {
    const int gw = C.bid * 8 + C.wave, NGW = C.G * 8, lane = C.lane; const int* dest = mi + MI_DEST;
    for (int m = gw; m < M; m += NGW) { const int d0 = dest[2 * m], d1 = dest[2 * m + 1];
        u32x2* hp = (u32x2*)(h + (size_t)m * D) + lane; const u32x2* y0 = (const u32x2*)(ys + (size_t)d0 * D) + lane; const u32x2* y1 = (const u32x2*)(ys + (size_t)d1 * D) + lane;
        const size_t slab = (size_t)MOE_ROWS * D / 4;
#pragma unroll
        for (int j = 0; j < 8; ++j) { const u32x2 hw = hp[64 * j], a0 = y0[64 * j], a1 = y0[slab + 64 * j], b0 = y1[64 * j], b1 = y1[slab + 64 * j];
            u32x2 w; w.x = pk2(bflo(hw.x) + ((bflo(a0.x) + bflo(a1.x)) + (bflo(b0.x) + bflo(b1.x))), bfhi(hw.x) + ((bfhi(a0.x) + bfhi(a1.x)) + (bfhi(b0.x) + bfhi(b1.x))));
            w.y = pk2(bflo(hw.y) + ((bflo(a0.y) + bflo(a1.y)) + (bflo(b0.y) + bflo(b1.y))), bfhi(hw.y) + ((bfhi(a0.y) + bfhi(a1.y)) + (bfhi(b0.y) + bfhi(b1.y)))); hp[64 * j] = w; } }
}

constexpr int CW_BGQ = 8192;
constexpr int BG_I1 = 56 * 16, BG_I2 = 8 * 56, BG_N1 = 8 * BG_I1, BG_NITEMS = BG_N1 + 8 * BG_I2;
__device__ __forceinline__ void bg_conv_item(LAS unsigned char* tile, int tid, int w, int L, KArgPtr ka, int item) {
    const float* src; ptrdiff_t du = 0; int srcN, K, n0, k0; unsigned char* dst;
    if (item < BG_N1) { const int e = item / BG_I1, rr = item - e * BG_I1, nb = rr >> 4, kb = rr & 15; n0 = nb * 256; k0 = kb * 128; srcN = EFF; K = 2048;
        src = (const float*)ka->in[27] + (size_t)e * 2048 * EFF; du = (const float*)ka->in[28] - (const float*)ka->in[27]; dst = ka->ws + O_WM1 + (size_t)e * (SZ_WM1 / 2); }
    else { const int j = item - BG_N1, e = j / BG_I2, rr = j - e * BG_I2, nb = rr / 56, kb = rr - nb * 56; n0 = nb * 256; k0 = kb * 128; srcN = 2048; K = EFF;
        src = (const float*)ka->in[29] + (size_t)e * EFF * 2048; dst = ka->ws + O_WM2 + (size_t)e * (SZ_WM2 / 2); }
    const float* sp;
    if (item < BG_N1) { const int n = n0 + 4 * L, tl = n >> 8, r = n & 255; sp = src + (r < 128 ? (ptrdiff_t)0 : du) + tl * 128 + (r & 127); } else sp = src + n0 + 4 * L;
    f32x4 v[16];
#pragma unroll
    for (int j = 0; j < 16; ++j) v[j] = __builtin_nontemporal_load((const f32x4*)(sp + (size_t)(k0 + 16 * w + j) * srcN));
#pragma unroll
    for (int q = 0; q < 4; ++q) { u32x4 o; o.x = pk4_fp8(v[0][q] * F8_WSCALE, v[1][q] * F8_WSCALE, v[2][q] * F8_WSCALE, v[3][q] * F8_WSCALE); o.y = pk4_fp8(v[4][q] * F8_WSCALE, v[5][q] * F8_WSCALE, v[6][q] * F8_WSCALE, v[7][q] * F8_WSCALE);
        o.z = pk4_fp8(v[8][q] * F8_WSCALE, v[9][q] * F8_WSCALE, v[10][q] * F8_WSCALE, v[11][q] * F8_WSCALE); o.w = pk4_fp8(v[12][q] * F8_WSCALE, v[13][q] * F8_WSCALE, v[14][q] * F8_WSCALE, v[15][q] * F8_WSCALE);
        *(LAS u32x4*)(tile + (4 * L + q) * 144 + w * 16) = o; }
    __syncthreads();
#pragma unroll
    for (int i = 0; i < 4; ++i) { const int idx = tid + 512 * i, n = idx >> 3, ch = idx & 7; const u32x4 o = *(const LAS u32x4*)(tile + n * 144 + ch * 16); *(u32x4*)(dst + (size_t)(n0 + n) * K + k0 + ch * 16) = o; }
    __syncthreads();
}
__device__ __forceinline__ void bg_drain(LAS unsigned char* lds, volatile LAS unsigned* misc, int wave, KArgPtr ka) {
    int ln; asm volatile("v_mbcnt_lo_u32_b32 %0, -1, 0\n\tv_mbcnt_hi_u32_b32 %0, -1, %0" : "=v"(ln));
    const int tid = wave * 64 + ln; unsigned* q = (unsigned*)(ka->ws) + CW_BGQ;
    for (;;) {
        if (tid == 0) misc[4] = xb_add(q, 1u);
        __syncthreads();
        const int item = (int)misc[4];
        __syncthreads();
        if (item >= BG_NITEMS) break;
        bg_conv_item(lds, tid, wave, ln, ka, item);
    }
}
__device__ __forceinline__ void xcd_barrier_bg(const XcdBarrier& b, LAS unsigned char* lds, KArgPtr ka) {
    asm volatile("s_waitcnt vmcnt(0)" ::: "memory");
    __syncthreads();
    volatile LAS unsigned* st = b.st;
    const bool t0 = xb_thread0(b.wave);
    if (t0) {
        unsigned* bar = b.bar; unsigned bx = b.x;
        asm volatile("" : "+s"(bar), "+s"(bx));
        __builtin_amdgcn_s_waitcnt(0);
        unsigned nloc = st[0], nx = st[1];
        if (nloc == 0u) { xcd_barrier_complete(bar, bx, nloc, nx); st[0] = nloc; st[1] = nx; }
        const unsigned old = xb_add(&bar[XB_XSUB(bx)], 1u);
        const unsigned gen = old / nloc;
        if (old + 1u == (gen + 1u) * nloc) {
            __builtin_amdgcn_fence(__ATOMIC_RELEASE, "agent");
            asm volatile("s_waitcnt vmcnt(0)" ::: "memory");
            const unsigned og = xb_add(&bar[XB_TOP], 1u);
            const unsigned tg = og / nx;
            if (og + 1u == (tg + 1u) * nx) xb_add(&bar[XB_TOPGEN], 1u);
            else XB_SPIN(xb_ld(&bar[XB_TOPGEN]) == tg, bar);
            __builtin_amdgcn_fence(__ATOMIC_ACQUIRE, "agent");
            xb_add(&bar[XB_XGEN(bx)], 1u);
            asm volatile("s_waitcnt vmcnt(0)" ::: "memory");
            st[2] = 0u;
        } else { st[2] = 2u; st[3] = gen; }
    }
    __syncthreads();
    if (st[2] != 0u) {
        int ln; asm volatile("v_mbcnt_lo_u32_b32 %0, -1, 0\n\tv_mbcnt_hi_u32_b32 %0, -1, %0" : "=v"(ln));
        const int tid = b.wave * 64 + ln; const unsigned gen = st[3];
        unsigned* bar = b.bar; unsigned bx = b.x; asm volatile("" : "+s"(bar), "+s"(bx));
        unsigned* q = bar - CW_BAR + CW_BGQ;
        bool qempty = (BG_NOWAITWORK != 0); unsigned spins = 0u;
        for (;;) {
            if (t0) { unsigned code = 0u;
                if (xb_ld(&bar[XB_XGEN(bx)]) == gen) { code = 1u;
                    if (!qempty) { const unsigned it = xb_add(q, 1u); if (it < (unsigned)BG_NITEMS) code = 2u + it; else qempty = true; }
                    if (code == 1u) { __builtin_amdgcn_s_sleep(2); if ((++spins & 255u) == 0u) { if (xb_ld(&bar[XB_TMO])) code = 0u; else if (spins > (XB_SPIN_CAP << 2)) { atomicAdd(&bar[XB_TMO], 1u); code = 0u; } } } }
                st[4] = code; }
            __syncthreads();
            const unsigned code = st[4];
            __syncthreads();
            if (code == 0u) break;
            if (code >= 2u) bg_conv_item(lds, tid, b.wave, ln, ka, (int)(code - 2u));
        }
        if (t0) { __builtin_amdgcn_fence(__ATOMIC_ACQUIRE, "agent"); asm volatile("s_waitcnt vmcnt(0)" ::: "memory"); }
    }
    __syncthreads();
}

enum { LP_INPROJ = 0, LP_POST, LP_MID1, LP_MID2, LP_MLAATT, LP_BRANCH, LP_WOUT, LP_NORM2, LP_ROUTE, LP_GATHER, LP_FFN1, LP_FFN2, LP_NORM3, LP_PLE, LP_NORM1, NLP };
constexpr int NPH = 1 + 2 * NLP;
__host__ __device__ inline bool phase_active(int ph) {
    if (ph == 0) return true;
    const int l = (ph - 1) / NLP, k = (ph - 1) % NLP;
    if ((k == LP_ROUTE || k == LP_GATHER) && l == 0) return false;
    if (k == LP_NORM1 && l == 1) return false;
    return true;
}

#ifdef ONLY_LP
#define IN(k) (((k) == 0 ? ((ONLY_LP) & 1) : (((ONLY_LP) >> (1 + (((k) - 1) % NLP))) & 1)) && lo <= (k) && (k) < hi)
#else
#define IN(k) (lo <= (k) && (k) < hi)
#endif
#if BG_CONV && FP8_MOE
#define SEAM(k) do { if (multi && (k) + 1 < hi) xcd_barrier_bg(bar, lds0, kargs()); } while (0)
#else
#define SEAM(k) do { if (multi && (k) + 1 < hi) xcd_barrier(bar); } while (0)
#endif
#define INF(i) ((const float*)ka->in[i])

template <int l>
__device__ __forceinline__ void layer_body(const int lo, const int hi, const bool multi, const XcdBarrier& bar, LAS unsigned char* const lds0, const int wave_s) {
        const int p0 = 1 + l * NLP;
        if (IN(p0 + LP_INPROJ)) {
            PHASE_LOCALS;
#if FP8_GATES
            { PlainSched S{WSP(bf16, O_HN), WSP(bf16, O_WIN + l * SZ_WIN), 2048, 2048, 2048, 32, PX_GATE / 256, C.G, C.bid};
              for (int rp = 0; rp < PB(1); ++rp) gemm_run(C, S, EpiBf16{WSP(bf16, O_PROJ), PROJ_N, 0, 1.0f}); }
            { PHASE_LOCALS; PlainSched S{WSP(bf16, O_HN8), WSP(bf16, O_WIN + l * SZ_WIN + (size_t)PX_GATE * 2048 * 2), 1024, 1024, 1024, 32, 24, C.G, C.bid};
              for (int rp = 0; rp < PB(1); ++rp) gemm_run_fp8(C, S, EpiBf16{WSP(bf16, O_PROJ), PROJ_N, PX_GATE, 1.0f / (F8_WSCALE * F8_XSCALE)}); }
#else
            PlainSched S{WSP(bf16, O_HN), WSP(bf16, O_WIN + l * SZ_WIN), 2048, 2048, 2048, 32, PROJ_N / 256, C.G, C.bid};
            for (int rp = 0; rp < PB(1); ++rp) gemm_run(C, S, EpiBf16{WSP(bf16, O_PROJ), PROJ_N, 0, 1.0f});
#endif
            SEAM(p0 + LP_INPROJ);
        }
        if (IN(p0 + LP_POST)) {
            PHASE_LOCALS;
            for (int rp = 0; rp < PB(2); ++rp) postproj_tokens(C, WSP(bf16, O_PROJ), (const int*)ka->in[2], INF(5) + l * 4096, INF(6) + l * 1024, INF(12) + l * 128, INF(13) + l * 128, INF(14) + l * 768, INF(15) + l * 512,
                            WSP(bf16, O_XC), WSP(bf16, O_QS), WSP(bf16, O_KS), WSP(bf16, O_QI), WSP(bf16, O_KI), WSP(bf16, O_CQN), WSP(bf16, O_CKVN));
            for (int rp = 0; rp < PB(3); ++rp) transpose_v(C, WSP(bf16, O_PROJ), PROJ_N, PX_AV, 128, WSP(bf16, O_VTS));
            SEAM(p0 + LP_POST);
        }
        if (IN(p0 + LP_MID1)) {
#ifndef SUBSEL
#define SUBSEL 15
#endif
            if (SUBSEL & 1) { PHASE_LOCALS; LruSched S{WSP(bf16, O_XC), WSP(bf16, O_WLRU + l * SZ_WLRU), 1024, 256, 256, C.G, C.bid};
              for (int rp = 0; rp < PB(4); ++rp) gemm_run(C, S, EpiLru{WSP(bf16, O_LA), WSP(bf16, O_LB), WSP(bf16, O_XC), INF(8) + l * 1024, INF(10) + l * 1024, (const float*)(WSP(int, O_MOEI) + MI_SP8) + l * 1024}); }
            if (SUBSEL & 2) { PHASE_LOCALS; PlainSched S{WSP(bf16, O_CQN), WSP(bf16, O_WUQ + l * SZ_WUQ), 768, 768, 768, 32, 6, C.G, C.bid}; for (int rp = 0; rp < PB(5); ++rp) gemm_run(C, S, EpiBf16{WSP(bf16, O_QMR), 1536, 0, 1.0f}); }
            if (SUBSEL & 4) { PHASE_LOCALS; PlainSched S{WSP(bf16, O_CKVN), WSP(bf16, O_WUKV + l * SZ_WUKV), 512, 512, 512, 32, 8, C.G, C.bid}; for (int rp = 0; rp < PB(5); ++rp) gemm_run(C, S, EpiBf16{WSP(bf16, O_KVMR), 2048, 0, 1.0f}); }
            if (SUBSEL & 8) { PHASE_LOCALS;
#if FAST_IDX
              for (int rp = 0; rp < PB(6); ++rp) indexer_mfma(C, WSP(bf16, O_PROJ), WSP(bf16, O_QI), WSP(bf16, O_KI), WSP(u64, O_SEL));
#else
              indexer_naive(C, WSP(bf16, O_PROJ), WSP(bf16, O_QI), WSP(bf16, O_KI), WSP(u64, O_SEL));
#endif
            }
            SEAM(p0 + LP_MID1);
        }
        if (IN(p0 + LP_MID2)) {
            { PHASE_LOCALS; for (int rp = 0; rp < PB(7); ++rp) lru_scan(C, WSP(bf16, O_LA), WSP(bf16, O_LB), WSP(bf16, O_PROJ), WSP(bf16, O_BR)); }
            { PHASE_LOCALS; for (int rp = 0; rp < PB(8); ++rp) mla_post(C, WSP(bf16, O_PROJ), (const int*)ka->in[2], WSP(bf16, O_QMR), WSP(bf16, O_KVMR), INF(18) + l * 192, INF(19) + l * 192, WSP(bf16, O_QM), WSP(bf16, O_KM));
              for (int rp = 0; rp < PB(8); ++rp) transpose_v(C, WSP(bf16, O_KVMR), 2048, 128, 256, WSP(bf16, O_VTM)); }
            { PHASE_LOCALS;
#if FAST_ATTN_S
              for (int rp = 0; rp < PB(9); ++rp) attn_mfma<128, true>(C, WSP(bf16, O_QS), WSP(bf16, O_KS), WSP(bf16, O_VTS), WSP(u64, O_SEL), WSP(bf16, O_BR) + (size_t)M * 1024);
#else
              sparse_attn_naive(C, WSP(bf16, O_PROJ), WSP(bf16, O_QS), WSP(bf16, O_KS), WSP(u64, O_SEL), WSP(bf16, O_BR) + (size_t)M * 1024);
#endif
            }
            SEAM(p0 + LP_MID2);
        }
        if (IN(p0 + LP_MLAATT)) {
            PHASE_LOCALS;
#if FAST_ATTN_M
            for (int rp = 0; rp < PB(10); ++rp) attn_mfma<192, false>(C, WSP(bf16, O_QM), WSP(bf16, O_KM), WSP(bf16, O_VTM), nullptr, WSP(bf16, O_BR) + (size_t)2 * M * 1024);
#else
            mla_attn_naive(C, WSP(bf16, O_QM), WSP(bf16, O_KM), WSP(bf16, O_KVMR), WSP(bf16, O_BR) + (size_t)2 * M * 1024);
#endif
            SEAM(p0 + LP_MLAATT);
        }
        if (IN(p0 + LP_BRANCH)) {
            PHASE_LOCALS;
            BranchSched S{WSP(bf16, O_BR), WSP(bf16, O_WBR + (size_t)l * 3 * SZ_WBR), 1024, 1024, 1024, C.G, C.bid};
            for (int rp = 0; rp < PB(11); ++rp) gemm_run(C, S, EpiBranch{WSP(bf16, O_PROJ), WSP(bf16, O_MF), WSP(bf16, O_MG)});
            SEAM(p0 + LP_BRANCH);
        }
        if (IN(p0 + LP_WOUT)) {
            PHASE_LOCALS;
            PlainSched S{WSP(bf16, O_MG), WSP(bf16, O_WOUT + l * SZ_WOUT), 2048, 2048, 2048, 32, 8, C.G, C.bid};
            if constexpr (l == 0) gemm_run(C, S, EpiResidT<false, true>{INF(0), WSP(bf16, O_H), D, 1.0f});
            else gemm_run(C, S, EpiResidT<true, true>{WSP(bf16, O_H), WSP(bf16, O_H), D, 1.0f});
            SEAM(p0 + LP_WOUT);
        }
        if (IN(p0 + LP_NORM2)) {
            PHASE_LOCALS; int* mi = WSP(int, O_MOEI);
            for (int rp = 0; rp < PB(12); ++rp)
            if (l == 0) rmsnorm_rows<false, (FP8_DENSE != 0) ? 1 : 0>(C, WSP(bf16, O_H), INF(22) + l * D, WSP(bf16, O_HN), nullptr, nullptr, nullptr);
            else rmsnorm_rows<true>(C, WSP(bf16, O_H), INF(22) + l * D, WSP(bf16, O_HN), INF(26), mi + MI_TOKE, (float*)(mi + MI_TOKG));
            SEAM(p0 + LP_NORM2);
        }
        if (l == 0) {
            if (IN(p0 + LP_FFN1)) {
                PHASE_LOCALS;
#if FP8_DENSE
                PlainSched S{WSP(bf16, O_HN), WSP(bf16, O_WD1), 1024, 1024, 1024, 32, 2 * DFF / 256, C.G, C.bid};
                for (int rp = 0; rp < PB(13); ++rp) gemm_run_fp8(C, S, EpiSwigluF8{WSP(unsigned char, O_HMID), DFF, 1.0f / (F8_WSCALE * F8_XSCALE)});
#else
                PlainSched S{WSP(bf16, O_HN), WSP(bf16, O_WD1), 2048, 2048, 2048, 32, 2 * DFF / 256, C.G, C.bid};
                for (int rp = 0; rp < PB(13); ++rp) gemm_run(C, S, EpiSwiglu{WSP(bf16, O_HMID), DFF});
#endif
                SEAM(p0 + LP_FFN1);
            }
            if (IN(p0 + LP_FFN2)) {
                PHASE_LOCALS;
#if FP8_DENSE
                PlainSched S{WSP(bf16, O_HMID), WSP(bf16, O_WD2), DFF / 2, DFF / 2, DFF / 2, 32, 8, C.G, C.bid};
                gemm_run_fp8(C, S, EpiResidT<true, true>{WSP(bf16, O_H), WSP(bf16, O_H), D, 1.0f / (F8_WSCALE * F8_HSCALE)});
#else
                PlainSched S{WSP(bf16, O_HMID), WSP(bf16, O_WD2), DFF, DFF, DFF, 32, 8, C.G, C.bid};
                gemm_run(C, S, EpiResidT<true, true>{WSP(bf16, O_H), WSP(bf16, O_H), D, 1.0f});
#endif
                SEAM(p0 + LP_FFN2);
            }
        } else {
            if (IN(p0 + LP_ROUTE)) { PHASE_LOCALS; for (int rp = 0; rp < PB(16); ++rp) moe_route(C, WSP(int, O_MOEI)); SEAM(p0 + LP_ROUTE); }
            if (IN(p0 + LP_GATHER)) { PHASE_LOCALS;
#if BG_CONV && FP8_MOE
              if (multi) bg_drain(lds0, bar.st, wave_s, ka);
#endif
              for (int rp = 0; rp < PB(16); ++rp)
#if FP8_MOE
                moe_gather_fp8(C, WSP(int, O_MOEI), WSP(bf16, O_HN), WSP(unsigned char, O_XS));
#else
                moe_gather(C, WSP(int, O_MOEI), WSP(bf16, O_HN), WSP(bf16, O_XS));
#endif
              SEAM(p0 + LP_GATHER); }
            if (IN(p0 + LP_FFN1)) {
                PHASE_LOCALS; int* mi = WSP(int, O_MOEI);
#if FP8_MOE
                MoeSched S{WSP(bf16, O_XS), WSP(bf16, O_WM1), 1024, 1024, 1024, 2 * EFF / 256, 4, 1, C.G, C.bid, mi + MI_BLKE, mi + MI_BSTART, mi[MI_NUSED], (size_t)EFF * 2048};
                for (int rp = 0; rp < PB(14); ++rp) gemm_run_fp8(C, S, EpiSwigluF8{WSP(unsigned char, O_HMID), EFF, 1.0f / (F8_WSCALE * F8_XSCALE)});
#else
                MoeSched S{WSP(bf16, O_XS), WSP(bf16, O_WM1), 2048, 2048, 2048, 2 * EFF / 256, 4, 1, C.G, C.bid, mi + MI_BLKE, mi + MI_BSTART, mi[MI_NUSED], (size_t)2 * EFF * 2048};
                for (int rp = 0; rp < PB(14); ++rp) gemm_run(C, S, EpiSwiglu{WSP(bf16, O_HMID), EFF});
#endif
                SEAM(p0 + LP_FFN1);
            }
            if (IN(p0 + LP_FFN2)) {
                PHASE_LOCALS; int* mi = WSP(int, O_MOEI);
#if FP8_MOE
                MoeSched S{WSP(bf16, O_HMID), WSP(bf16, O_WM2), EFF / 2, EFF / 2, EFF / 4, 8, 8, 2, C.G, C.bid, mi + MI_BLKE, mi + MI_BSTART, mi[MI_NUSED], (size_t)1024 * EFF};
                for (int rp = 0; rp < PB(15); ++rp) gemm_run_fp8(C, S, EpiScaleRow{WSP(bf16, O_YS), (const float*)(mi + MI_ROWG), 1.0f / (F8_WSCALE * F8_HSCALE)});
#else
                MoeSched S{WSP(bf16, O_HMID), WSP(bf16, O_WM2), EFF, EFF, EFF / 2, 8, 8, 2, C.G, C.bid, mi + MI_BLKE, mi + MI_BSTART, mi[MI_NUSED], (size_t)2048 * EFF};
                for (int rp = 0; rp < PB(15); ++rp) gemm_run(C, S, EpiScaleRow{WSP(bf16, O_YS), (const float*)(mi + MI_ROWG), 1.0f});
#endif
                SEAM(p0 + LP_FFN2);
            }
        }
        if (IN(p0 + LP_NORM3)) {
            { PHASE_LOCALS;
              if (l == 1) { moe_combine(C, WSP(int, O_MOEI), WSP(bf16, O_YS), WSP(bf16, O_H)); asm volatile("s_waitcnt vmcnt(0)" ::: "memory"); }
              rmsnorm_rows<false>(C, WSP(bf16, O_H), INF(30) + l * D, WSP(bf16, O_HN), nullptr, nullptr, nullptr); }
            { PHASE_LOCALS; PlainSched S{WSP(bf16, O_PBF + l * SZ_PBF), WSP(bf16, O_WPP + l * SZ_WPP), 256, 256, 256, 32, 8, C.G, C.bid}; for (int rp = 0; rp < PB(17); ++rp) gemm_run(C, S, EpiBf16{WSP(bf16, O_PP), D, 0, 1.0f}); }
            SEAM(p0 + LP_NORM3);
        }
        if (IN(p0 + LP_PLE)) {
            PHASE_LOCALS;
            PlainSched S{WSP(bf16, O_HN), WSP(bf16, O_WPG + l * SZ_WPG), 2048, 2048, 2048, 32, 8, C.G, C.bid};
            if constexpr (l == 1) gemm_run(C, S, EpiPleT<false>{WSP(bf16, O_H), ka->out, WSP(bf16, O_PP)});
            else gemm_run(C, S, EpiPleT<true>{WSP(bf16, O_H), WSP(bf16, O_H), WSP(bf16, O_PP)});
            SEAM(p0 + LP_PLE);
        }
        if (l == 0 && IN(p0 + LP_NORM1)) {
            PHASE_LOCALS;
            rmsnorm_rows<false, FP8_GATES ? 2 : 0>(C, WSP(bf16, O_H), INF(3) + D, WSP(bf16, O_HN), nullptr, nullptr, nullptr, WSP(unsigned char, O_HN8));
            SEAM(p0 + LP_NORM1);
        }
}

__global__ void __launch_bounds__(512, 2) mk_fwd(Args a) {
    extern __shared__ __attribute__((aligned(16))) unsigned char lds_raw[];
    LAS unsigned char* const lds0 = (LAS unsigned char*)lds_raw;
    volatile LAS unsigned* MISC = (volatile LAS unsigned*)(lds0 + LDS_MISC);
    const int wave_s = __builtin_amdgcn_readfirstlane((int)threadIdx.x >> 6);
    if (threadIdx.x < 16) MISC[threadIdx.x] = 0u;
    __syncthreads();
    const int lo = a.ph_lo, hi = a.ph_hi;
    XcdBarrier bar; bar.bar = (unsigned*)(a.ws) + CW_BAR; bar.x = 0; bar.st = MISC; bar.wave = wave_s;
    const bool multi = (hi - lo) > 1;
    if (multi) bar = xcd_barrier_post((unsigned*)(a.ws) + CW_BAR, MISC, wave_s);

    if (IN(0)) {
        PHASE_LOCALS;
        for (int rp = 0; rp < PB(0); ++rp) {
        for (int l = 0; l < 2; ++l) {
#if FP8_GATES
            conv_job(C, WSP(bf16, O_WIN + l * SZ_WIN), PX_GATE, 2048, 13712, RsWin{INF(4) + (size_t)l * 2048 * 13712});
            conv_job_fp8(C, WSP(unsigned char, O_WIN + l * SZ_WIN + (size_t)PX_GATE * 2048 * 2), 6144, 2048, 13712, RsPlain{INF(4) + (size_t)l * 2048 * 13712 + 7568}, F8_WSCALE);
#else
            conv_job(C, WSP(bf16, O_WIN + l * SZ_WIN), PROJ_N, 2048, 13712, RsWin{INF(4) + (size_t)l * 2048 * 13712});
#endif
            conv_job(C, WSP(bf16, O_WUQ + l * SZ_WUQ), 1536, 768, 1536, RsPlain{INF(16) + (size_t)l * 768 * 1536});
            conv_job(C, WSP(bf16, O_WUKV + l * SZ_WUKV), 2048, 512, 2048, RsPlain{INF(17) + (size_t)l * 512 * 2048});
            for (int n = 0; n < 3; ++n) conv_job(C, WSP(bf16, O_WBR + (l * 3 + n) * SZ_WBR), 2048, 1024, 2048, RsPlain{INF(20) + (size_t)(l * 3 + n) * 1024 * 2048});
            conv_job(C, WSP(bf16, O_WOUT + l * SZ_WOUT), 2048, 2048, 2048, RsPlain{INF(21) + (size_t)l * 2048 * 2048});
            conv_job(C, WSP(bf16, O_WPG + l * SZ_WPG), 2048, 2048, 2048, RsPlain{INF(31) + (size_t)l * 2048 * 2048});
            conv_job(C, WSP(bf16, O_WPP + l * SZ_WPP), 2048, 256, 2048, RsPlain{INF(32) + (size_t)l * 256 * 2048});
            { bf16* dst = WSP(bf16, O_WLRU + l * SZ_WLRU); const float* wa = INF(7) + (size_t)l * 8 * 128 * 128; const float* wx = INF(9) + (size_t)l * 8 * 128 * 128;
              for (int i = C.bid * 512 + C.tid; i < 2048 * 256; i += C.G * 512) { const int n = i >> 8, k = i & 255, pn = n >> 8, r = n & 255, gt = r >> 7, d = r & 127, kb = k >> 7, cc = k & 127;
                  const bool on = (2 * (pn >> 1) + kb) == pn; const float wv = (wa + (gt ? (wx - wa) : (ptrdiff_t)0))[(size_t)(pn * 128 + cc) * 128 + d]; dst[i] = on ? f2bf(wv) : (bf16)0; } }
        }
#if FP8_DENSE
        conv_job_fp8(C, WSP(unsigned char, O_WD1), 2 * DFF, 2048, DFF, RsGU{INF(23), INF(24) - INF(23)}, F8_WSCALE);
        conv_job_fp8(C, WSP(unsigned char, O_WD2), 2048, DFF, 2048, RsPlain{INF(25)}, F8_WSCALE);
#else
        conv_job(C, WSP(bf16, O_WD1), 2 * DFF, 2048, DFF, RsGU{INF(23), INF(24) - INF(23)});
        conv_job(C, WSP(bf16, O_WD2), 2048, DFF, 2048, RsPlain{INF(25)});
#endif
        for (int e = 0; e < ((BG_CONV && FP8_MOE && multi) ? 0 : 8); ++e) {
#if FP8_MOE
            conv_job_fp8(C, WSP(unsigned char, O_WM1 + e * (SZ_WM1 / 2)), 2 * EFF, 2048, EFF, RsGU{INF(27) + (size_t)e * 2048 * EFF, INF(28) - INF(27)}, F8_WSCALE);
            conv_job_fp8(C, WSP(unsigned char, O_WM2 + e * (SZ_WM2 / 2)), 2048, EFF, 2048, RsPlain{INF(29) + (size_t)e * EFF * 2048}, F8_WSCALE);
#else
            conv_job(C, WSP(bf16, O_WM1 + e * SZ_WM1), 2 * EFF, 2048, EFF, RsGU{INF(27) + (size_t)e * 2048 * EFF, INF(28) - INF(27)});
            conv_job(C, WSP(bf16, O_WM2 + e * SZ_WM2), 2048, EFF, 2048, RsPlain{INF(29) + (size_t)e * EFF * 2048});
#endif
        }
        { float* sp8 = (float*)(WSP(int, O_MOEI) + MI_SP8); const float* lam = INF(11); for (int i = C.bid * 512 + C.tid; i < 2048; i += C.G * 512) sp8[i] = 8.0f * log1pf(__expf(-lam[i])); }
        { bf16* pb = WSP(bf16, O_PBF); const float* p = INF(1); for (size_t i = (size_t)C.bid * 512 + C.tid; i < (size_t)2 * M * 256 / 4; i += (size_t)C.G * 512) { const f32x4 v = ((const f32x4*)p)[i]; u32x2 w; w.x = pk2(v[0], v[1]); w.y = pk2(v[2], v[3]); ((u32x2*)pb)[i] = w; } }
        rmsnorm_rows<false, FP8_GATES ? 2 : 0, false>(C, INF(0), INF(3), WSP(bf16, O_HN), nullptr, nullptr, nullptr, WSP(unsigned char, O_HN8));
        }
        SEAM(0);
    }

    layer_body<0>(lo, hi, multi, bar, lds0, wave_s);
    layer_body<1>(lo, hi, multi, bar, lds0, wave_s);
#undef IN
#undef SEAM
#undef INF
}

extern "C" void kernel_launch(void* const* d_in, const int* in_sizes, int n_in, void* d_out, int out_size, void* d_ws, size_t ws_size, hipStream_t stream) {
    static int grid = 0;
    if (grid == 0) {
        if (n_in != 33 || out_size != M * D || ws_size < WS_END) { fprintf(stderr, "kernel_launch: unexpected problem (n_in %d, out %d, ws %zu < %zu)\n", n_in, out_size, ws_size, (size_t)WS_END); grid = -1; return; }
        int dev = 0, cus = 0, per_cu = 0;
        if (hipGetDevice(&dev) != hipSuccess || hipDeviceGetAttribute(&cus, hipDeviceAttributeMultiprocessorCount, dev) != hipSuccess) { grid = -1; return; }
        if (hipFuncSetAttribute((const void*)mk_fwd, hipFuncAttributeMaxDynamicSharedMemorySize, LDS_BYTES) != hipSuccess) { fprintf(stderr, "kernel_launch: hipFuncSetAttribute failed\n"); grid = -1; return; }
        if (hipOccupancyMaxActiveBlocksPerMultiprocessor(&per_cu, (const void*)mk_fwd, 512, LDS_BYTES) != hipSuccess || per_cu < 1) fprintf(stderr, "kernel_launch: occupancy query says %d\n", per_cu);
        (void)hipGetLastError();
        grid = cus;
    }
    if (grid < 0) return;
    (void)hipMemsetAsync(d_ws, 0, CTL_BYTES, stream);
    Args a{};
    for (int i = 0; i < 33; ++i) a.in[i] = d_in[i];
    a.out = (float*)d_out; a.ws = (unsigned char*)d_ws;
#if N_LAUNCH_MODE == 1
    a.ph_lo = 0; a.ph_hi = NPH;
    hipLaunchKernelGGL(mk_fwd, dim3(grid), dim3(512), LDS_BYTES, stream, a);
#else
    for (int ph = 0; ph < NPH; ++ph) { if (!phase_active(ph)) continue; a.ph_lo = ph; a.ph_hi = ph + 1; hipLaunchKernelGGL(mk_fwd, dim3(grid), dim3(512), LDS_BYTES, stream, a); }
#endif
}
```

```cpp
#include <hip/hip_runtime.h>
#include <cstdio>
#include <cstdint>

#ifndef FAST_GEMM
#define FAST_GEMM 1
#endif
#ifndef FAST_CONV
#define FAST_CONV 1
#endif
#ifndef FAST_ATTN_S
#define FAST_ATTN_S 1
#endif
#ifndef FAST_ATTN_M
#define FAST_ATTN_M 1
#endif
#ifndef FAST_IDX
#define FAST_IDX 1
#endif
#ifndef PROBE_ID
#define PROBE_ID -1
#endif
#define PB(id) ((PROBE_ID == (id)) ? 2 : 1)
#ifndef FP8_MOE
#define FP8_MOE 1
#endif
#ifndef FP8_DENSE
#define FP8_DENSE 1
#endif
#ifndef FP8_GATES
#define FP8_GATES 1
#endif
#ifndef BG_NOWAITWORK
#define BG_NOWAITWORK 0
#endif
#ifndef BG_CONV
#define BG_CONV 1
#endif
#ifndef N_LAUNCH_MODE
#define N_LAUNCH_MODE 1
#endif

#define LAS __attribute__((address_space(3)))
typedef unsigned short bf16;
typedef short bf16x8 __attribute__((ext_vector_type(8)));
typedef float f32x4 __attribute__((ext_vector_type(4)));
typedef unsigned u32x4 __attribute__((ext_vector_type(4)));
typedef unsigned u32x2 __attribute__((ext_vector_type(2)));
typedef unsigned long long u64;

constexpr int NB = 4, T = 2048, M = NB * T, D = 2048;
constexpr int PROJ_N = 13824;
constexpr int PX_LRUX = 0, PX_LRUG = 1024, PX_AQ = 2048, PX_AK = 3072, PX_AV = 4096, PX_IQ = 5120, PX_CQ = 6144, PX_CKV = 6912, PX_IK = 7424, PX_KR = 7488, PX_IW = 7552, PX_GATE = 7680;
constexpr int DFF = 5632, EFF = 7168, NEXP = 8, MOE_ROWS = 18432, MOE_BLKS = 72;
constexpr float EPS = 1e-6f;
constexpr float LOG2_THETA = 13.287712379549449f;
constexpr float INV_2PI = 0.15915494309189535f;

constexpr size_t CTL_BYTES = 1u << 20;
constexpr size_t SZ_WIN = (size_t)PROJ_N * 2048 * 2, SZ_WLRU = (size_t)2048 * 256 * 2, SZ_WUQ = (size_t)1536 * 768 * 2, SZ_WUKV = (size_t)2048 * 512 * 2,
                 SZ_WBR = (size_t)2048 * 1024 * 2, SZ_WOUT = (size_t)2048 * 2048 * 2, SZ_WD1 = (size_t)2 * DFF * 2048 * 2, SZ_WD2 = (size_t)2048 * DFF * 2,
                 SZ_WM1 = (size_t)2 * EFF * 2048 * 2, SZ_WM2 = (size_t)2048 * EFF * 2, SZ_WPG = (size_t)2048 * 2048 * 2, SZ_WPP = (size_t)2048 * 256 * 2, SZ_PBF = (size_t)M * 256 * 2;
constexpr size_t O_WIN = CTL_BYTES;
constexpr size_t O_WLRU = O_WIN + 2 * SZ_WIN;
constexpr size_t O_WUQ = O_WLRU + 2 * SZ_WLRU;
constexpr size_t O_WUKV = O_WUQ + 2 * SZ_WUQ;
constexpr size_t O_WBR = O_WUKV + 2 * SZ_WUKV;
constexpr size_t O_WOUT = O_WBR + 6 * SZ_WBR;
constexpr size_t O_WD1 = O_WOUT + 2 * SZ_WOUT;
constexpr size_t O_WD2 = O_WD1 + SZ_WD1;
constexpr size_t O_WM1 = O_WD2 + SZ_WD2;
constexpr size_t O_WM2 = O_WM1 + 8 * SZ_WM1;
constexpr size_t O_WPG = O_WM2 + 8 * SZ_WM2;
constexpr size_t O_WPP = O_WPG + 2 * SZ_WPG;
constexpr size_t O_PBF = O_WPP + 2 * SZ_WPP;
constexpr size_t O_H = O_PBF + 2 * SZ_PBF;
constexpr size_t O_HN = O_H + (size_t)M * D * 4;
constexpr size_t O_PP = O_HN + (size_t)M * D * 2;
constexpr size_t O_MOEI = O_PP + (size_t)M * D * 2;
constexpr size_t O_HN8 = O_MOEI + (1u << 20);
constexpr size_t O_SCR = O_HN8 + (size_t)M * D;
constexpr size_t O_PROJ = O_SCR;
constexpr size_t O_XC = O_PROJ + (size_t)M * PROJ_N * 2;
constexpr size_t O_LA = O_XC + (size_t)M * 1024 * 2;
constexpr size_t O_LB = O_LA + (size_t)M * 1024 * 4;
constexpr size_t O_BR = O_LB + (size_t)M * 1024 * 4;
constexpr size_t O_QS = O_BR + (size_t)3 * M * 1024 * 2;
constexpr size_t O_KS = O_QS + (size_t)M * 1024 * 2;
constexpr size_t O_VTS = O_KS + (size_t)M * 1024 * 2;
constexpr size_t O_QI = O_VTS + (size_t)M * 1024 * 2;
constexpr size_t O_KI = O_QI + (size_t)M * 1024 * 2;
constexpr size_t O_SEL = O_KI + (size_t)M * 64 * 2;
constexpr size_t O_CQN = O_SEL + (size_t)M * 32 * 8;
constexpr size_t O_CKVN = O_CQN + (size_t)M * 768 * 2;
constexpr size_t O_QMR = O_CKVN + (size_t)M * 512 * 2;
constexpr size_t O_KVMR = O_QMR + (size_t)M * 1536 * 2;
constexpr size_t O_QM = O_KVMR + (size_t)M * 2048 * 2;
constexpr size_t O_KM = O_QM + (size_t)M * 1536 * 2;
constexpr size_t O_VTM = O_KM + (size_t)M * 1536 * 2;
constexpr size_t O_MF = O_VTM + (size_t)M * 1024 * 2;
constexpr size_t O_MG = O_MF + (size_t)M * D * 4;
constexpr size_t O_MIXEND = O_MG + (size_t)M * D * 2;
constexpr size_t O_HMID = O_SCR;
constexpr size_t O_XS = O_HMID + (size_t)MOE_ROWS * EFF * 2;
constexpr size_t O_YS = O_XS + (size_t)MOE_ROWS * D * 2;
constexpr size_t O_FFNEND = O_YS + (size_t)2 * MOE_ROWS * D * 4;
constexpr size_t WS_END = O_MIXEND > O_FFNEND ? O_MIXEND : O_FFNEND;
static_assert(WS_END <= 1998027776ull, "workspace map exceeds the guaranteed d_ws size");
static_assert((O_H % 256) == 0 && (O_SCR % 256) == 0 && (O_XC % 256) == 0, "alignment");
constexpr int MI_TOKE = 0;
constexpr int MI_TOKG = MI_TOKE + 2 * M;
constexpr int MI_DEST = MI_TOKG + 2 * M;
constexpr int MI_ROWTOK = MI_DEST + 2 * M;
constexpr int MI_ROWG = MI_ROWTOK + MOE_ROWS;
constexpr int MI_BLKE = MI_ROWG + MOE_ROWS;
constexpr int MI_NUSED = MI_BLKE + 128;
constexpr int MI_BSTART = MI_NUSED + 16;
constexpr int MI_SP8 = MI_BSTART + 64;
static_assert((MI_SP8 + 2048) * 4 <= (1 << 20), "moe tables");

#define XB_TMO      128
#define XB_XCNT(j)  (256  + 64 * (j))
#define XB_XSUB(j)  (1280 + 64 * (j))
#define XB_XGEN(j)  (2304 + 64 * (j))
#define XB_TOP      3328
#define XB_TOPGEN   3392
#define XCD_BAR_WORDS 3456
#define XB_SPIN_CAP (1u << 18)
constexpr int CW_BAR = 4096;

constexpr int LDS_RING = 131072, LDS_MISC = LDS_RING + 256, LDS_BYTES = 147456;

__device__ __forceinline__ unsigned pk2(float lo, float hi) { unsigned r; asm("v_cvt_pk_bf16_f32 %0, %1, %2" : "=v"(r) : "v"(lo), "v"(hi)); return r; }
__device__ __forceinline__ bf16 f2bf(float f) { return (bf16)(pk2(f, 0.f) & 0xffffu); }
__device__ __forceinline__ float bf2f(bf16 b) { return __builtin_bit_cast(float, (unsigned)b << 16); }
__device__ __forceinline__ float bflo(unsigned w) { return __builtin_bit_cast(float, w << 16); }
__device__ __forceinline__ float bfhi(unsigned w) { return __builtin_bit_cast(float, w & 0xffff0000u); }
__device__ __forceinline__ unsigned pk4_fp8(float a, float b, float c, float d) { int p = 0; p = __builtin_amdgcn_cvt_pk_fp8_f32(a, b, p, false); p = __builtin_amdgcn_cvt_pk_fp8_f32(c, d, p, true); return (unsigned)p; }
constexpr float F8_WSCALE = 512.f, F8_XSCALE = 16.f, F8_HSCALE = 8.f;
__device__ __forceinline__ float wave_sum(float v) {
#pragma unroll
    for (int o = 1; o < 64; o <<= 1) v += __shfl_xor(v, o);
    return v;
}
__device__ __forceinline__ int wave_sum_i(int v) {
    v += __builtin_amdgcn_update_dpp(0, v, 0x111, 0xf, 0xf, true);
    v += __builtin_amdgcn_update_dpp(0, v, 0x112, 0xf, 0xf, true);
    v += __builtin_amdgcn_update_dpp(0, v, 0x114, 0xf, 0xf, true);
    v += __builtin_amdgcn_update_dpp(0, v, 0x118, 0xf, 0xf, true);
    return __builtin_amdgcn_readlane(v, 15) + __builtin_amdgcn_readlane(v, 31) + __builtin_amdgcn_readlane(v, 47) + __builtin_amdgcn_readlane(v, 63);
}
__device__ __forceinline__ float wave_max(float v) {
#pragma unroll
    for (int o = 1; o < 64; o <<= 1) v = fmaxf(v, __shfl_xor(v, o));
    return v;
}
__device__ __forceinline__ float relu_(float x) { return __builtin_amdgcn_fmed3f(x, 0.f, __builtin_inff()); }
__device__ __forceinline__ float sigmoidf_(float x) { return __builtin_amdgcn_rcpf(1.0f + __expf(-x)); }
__device__ __forceinline__ float gelu_tanh(float x) { const float z = 0.7978845608028654f * (x + 0.044715f * x * x * x); const float e = __expf(2.0f * z); return x * (1.0f - __builtin_amdgcn_rcpf(1.0f + e)); }
__device__ __forceinline__ float rd_lane(float v, int l) { return __builtin_bit_cast(float, __builtin_amdgcn_readlane(__builtin_bit_cast(int, v), l)); }
__device__ __forceinline__ unsigned rd_lane_u(unsigned v, int l) { return (unsigned)__builtin_amdgcn_readlane((int)v, l); }

__device__ __forceinline__ unsigned xb_ld(unsigned* p)              { return __hip_atomic_load(p, __ATOMIC_RELAXED, __HIP_MEMORY_SCOPE_AGENT); }
__device__ __forceinline__ unsigned xb_add(unsigned* p, unsigned v) { return __hip_atomic_fetch_add(p, v, __ATOMIC_RELAXED, __HIP_MEMORY_SCOPE_AGENT); }
__device__ __forceinline__ unsigned xb_xcc_id() { return (unsigned)__builtin_amdgcn_s_getreg((3 << 11) | 20) & 0xFu; }
#define XB_SPIN(cond, bar) do { unsigned _sp = 0; while (cond) { __builtin_amdgcn_s_sleep(1); \
    if ((++_sp & 255u) == 0u) { if (xb_ld(&(bar)[XB_TMO])) break; if (_sp > XB_SPIN_CAP) { atomicAdd(&(bar)[XB_TMO], 1u); break; } } } } while (0)
struct XcdBarrier { unsigned* bar; unsigned x; volatile LAS unsigned* st; int wave; };
__device__ __forceinline__ bool xb_thread0(int wave) { return wave == 0 && __builtin_amdgcn_mbcnt_hi(~0u, __builtin_amdgcn_mbcnt_lo(~0u, 0u)) == 0u; }
__device__ __forceinline__ XcdBarrier xcd_barrier_post(unsigned* bar, volatile LAS unsigned* st, int wave) {
    XcdBarrier b; b.bar = bar; b.x = xb_xcc_id(); b.st = st; b.wave = wave;
    if (xb_thread0(wave)) (void)xb_add(&bar[XB_XCNT(b.x)], 1u);
    return b;
}
__device__ __forceinline__ void xcd_barrier_complete(unsigned* bar, unsigned x, unsigned& nloc, unsigned& nx) {
    const unsigned G = gridDim.x * gridDim.y * gridDim.z;
    unsigned sum, cnt, mine, sp = 0u;
    for (;;) {
        sum = 0u; cnt = 0u; mine = 0u;
#pragma unroll
        for (unsigned j = 0; j < 16; ++j) { const unsigned c = xb_ld(&bar[XB_XCNT(j)]); sum += c; cnt += (c > 0u) ? 1u : 0u; mine = (j == x) ? c : mine; }
        if (sum == G) break;
        __builtin_amdgcn_s_sleep(1);
        if ((++sp & 255u) == 0u) { if (xb_ld(&bar[XB_TMO])) break; if (sp > XB_SPIN_CAP) { atomicAdd(&bar[XB_TMO], 1u); break; } }
    }
    nloc = mine > 0u ? mine : 1u; nx = cnt > 0u ? cnt : 1u;
}
__device__ __forceinline__ void xcd_barrier(const XcdBarrier& b) {
    asm volatile("s_waitcnt vmcnt(0)" ::: "memory");
    __syncthreads();
    if (xb_thread0(b.wave)) {
        unsigned* bar = b.bar; unsigned bx = b.x;
        asm volatile("" : "+s"(bar), "+s"(bx));
        __builtin_amdgcn_s_waitcnt(0);
        unsigned nloc = b.st[0], nx = b.st[1];
        if (nloc == 0u) { xcd_barrier_complete(bar, bx, nloc, nx); b.st[0] = nloc; b.st[1] = nx; }
        const unsigned old = xb_add(&bar[XB_XSUB(bx)], 1u);
        const unsigned gen = old / nloc;
        if (old + 1u == (gen + 1u) * nloc) {
            __builtin_amdgcn_fence(__ATOMIC_RELEASE, "agent");
            asm volatile("s_waitcnt vmcnt(0)" ::: "memory");
            const unsigned og = xb_add(&bar[XB_TOP], 1u);
            const unsigned tg = og / nx;
            if (og + 1u == (tg + 1u) * nx) xb_add(&bar[XB_TOPGEN], 1u);
            else XB_SPIN(xb_ld(&bar[XB_TOPGEN]) == tg, bar);
            __builtin_amdgcn_fence(__ATOMIC_ACQUIRE, "agent");
            xb_add(&bar[XB_XGEN(bx)], 1u);
            asm volatile("s_waitcnt vmcnt(0)" ::: "memory");
        } else {
            XB_SPIN(xb_ld(&bar[XB_XGEN(bx)]) == gen, bar);
            __builtin_amdgcn_fence(__ATOMIC_ACQUIRE, "agent");
            asm volatile("s_waitcnt vmcnt(0)" ::: "memory");
        }
    }
    __syncthreads();
}

struct Args { const void* in[33]; float* out; unsigned char* ws; int ph_lo, ph_hi; };
struct Ctx {
    LAS unsigned char* lds; int tid, lane, wave, bid, G;
};
#define WSP(T_, off) ((T_*)(wsb + (off)))
typedef const __attribute__((address_space(4))) Args* KArgPtr;
__device__ __forceinline__ KArgPtr kargs() { KArgPtr p = (KArgPtr)__builtin_amdgcn_kernarg_segment_ptr(); asm volatile("" : "+s"(p)); return p; }
__device__ __forceinline__ Ctx make_ctx(LAS unsigned char* lds, int wave_s) { Ctx C; int w = wave_s; asm volatile("" : "+s"(w)); int ln; asm volatile("v_mbcnt_lo_u32_b32 %0, -1, 0\n\tv_mbcnt_hi_u32_b32 %0, -1, %0" : "=v"(ln)); C.lds = lds; C.lane = ln; C.wave = w; C.tid = w * 64 + ln; C.bid = blockIdx.x; C.G = gridDim.x; return C; }
#define PHASE_LOCALS __builtin_amdgcn_sched_barrier(0); KArgPtr ka = kargs(); unsigned char* const wsb = ka->ws; (void)wsb; Ctx C = make_ctx(lds0, wave_s)

struct Unit { int pm, pn, g, k; };
__device__ __forceinline__ bool static_tile(int i, int G, int c, int nM, int nN, int& pm, int& pn) {
    const int nwg = nM * nN; const long L = (long)i * G + c; if (L >= nwg) return false;
    int wgid = (int)L; { const int q = nwg / 8, r = nwg % 8, xcd = wgid % 8, off = wgid / 8; wgid = (xcd < r ? xcd * (q + 1) : r * (q + 1) + (xcd - r) * q) + off; }
    const int nig = 8 * nN, gid = wgid / nig, fm = gid * 8, gsz = (nM - fm) < 8 ? (nM - fm) : 8;
    pm = fm + ((wgid % nig) % gsz); pn = (wgid % nig) / gsz; return true;
}
struct PlainSched {
    const bf16* A; const bf16* Bt; int lda, ldb, K, nM, nN, G, c;
    __device__ __forceinline__ bool next(int i, Unit& u) const { u.g = 0; u.k = 0; return static_tile(i, G, c, nM, nN, u.pm, u.pn); }
    __device__ __forceinline__ const char* aptr(const Unit& u) const { return (const char*)(A + (size_t)u.pm * 256 * lda); }
    __device__ __forceinline__ const char* bptr(const Unit& u) const { return (const char*)(Bt + (size_t)u.pn * 256 * ldb); }
};
struct LruSched {
    const bf16* A; const bf16* Bt; int lda, ldb, K, G, c;
    __device__ __forceinline__ bool next(int i, Unit& u) const { u.g = 0; u.k = 0; return static_tile(i, G, c, 32, 8, u.pm, u.pn); }
    __device__ __forceinline__ const char* aptr(const Unit& u) const { return (const char*)(A + (size_t)u.pm * 256 * lda + 256 * (u.pn >> 1)); }
    __device__ __forceinline__ const char* bptr(const Unit& u) const { return (const char*)(Bt + (size_t)u.pn * 256 * ldb); }
};
struct BranchSched {
    const bf16* A; const bf16* Bt; int lda, ldb, K, G, c;
    __device__ __forceinline__ bool next(int i, Unit& u) const { const int tile = c + G * (i / 3); if (tile >= 256) return false; u.g = i % 3; u.k = 0;
        const int x = tile & 7, j = tile >> 3; u.pm = 4 * x + (j >> 3); u.pn = j & 7; return true; }
    __device__ __forceinline__ const char* aptr(const Unit& u) const { return (const char*)(A + ((size_t)u.g * M + (size_t)u.pm * 256) * lda); }
    __device__ __forceinline__ const char* bptr(const Unit& u) const { return (const char*)(Bt + ((size_t)u.g * 2048 + (size_t)u.pn * 256) * ldb); }
};
struct MoeSched {
    const bf16* A; const bf16* Bt; int lda, ldb, K, nN, GP, KS, G, c; const int* blke; const int* bstart; int nused; size_t estride;
    __device__ __forceinline__ bool next(int i, Unit& u) const {
        const int nwg = nused * nN * KS; const long L = (long)i * G + c; if (L >= nwg) return false;
        int p = (int)L; { const int q = nwg / 8, r = nwg % 8, xcd = p % 8, off = p / 8; p = (xcd < r ? xcd * (q + 1) : r * (q + 1) + (xcd - r) * q) + off; }
        int e = 0, b0 = 0, b1 = __builtin_amdgcn_readfirstlane(bstart[1]);
#pragma unroll
        for (int j = 1; j < 8; ++j) { const int bj = __builtin_amdgcn_readfirstlane(bstart[j]), bn = __builtin_amdgcn_readfirstlane(bstart[j + 1]); if (p >= bj * nN * KS) { e = j; b0 = bj; b1 = bn; } }
        const int nb = b1 - b0, qq = p - b0 * nN * KS, ks = qq / (nb * nN), q = qq - ks * (nb * nN), per = nb * GP, g4 = q / per, rem = q - g4 * per, bl = rem / GP, pl = rem - bl * GP;
        u.pm = b0 + bl; u.pn = g4 * GP + pl; u.g = e; u.k = ks; return true;
    }
    __device__ __forceinline__ const char* aptr(const Unit& u) const { return (const char*)(A + (size_t)u.pm * 256 * lda + (size_t)u.k * K); }
    __device__ __forceinline__ const char* bptr(const Unit& u) const { return (const char*)(Bt + (size_t)u.g * estride + (size_t)u.pn * 256 * ldb + (size_t)u.k * K); }
};

struct EpiNoCol { };
struct EpiBf16 { static constexpr bool DUAL = false, PRELOAD = false; bf16* O; int ldc; int coff; float sc;
    __device__ __forceinline__ void store(const Unit& u, int r, int c, f32x4 v) const {
        u32x2 w; w.x = pk2(v[0] * sc, v[1] * sc); w.y = pk2(v[2] * sc, v[3] * sc); *(u32x2*)(O + (size_t)(u.pm * 256 + r) * ldc + coff + u.pn * 256 + c) = w; } };
struct EpiLru { static constexpr bool DUAL = true, PRELOAD = true; bf16* la; bf16* lb; const bf16* xc; const float* ba; const float* bx; const float* sp8;
    struct Data { u32x2 xw; }; struct Col { f32x4 ba4, bx4, sp4; };
    __device__ __forceinline__ Col cload(const Unit& u, int c) const { const int col = u.pn * 128 + c; Col q; q.ba4 = *(const f32x4*)(ba + col); q.bx4 = *(const f32x4*)(bx + col); q.sp4 = *(const f32x4*)(sp8 + col); return q; }
    __device__ __forceinline__ Data load(const Unit& u, int r, int c) const { Data d; d.xw = *(const u32x2*)(xc + (size_t)(u.pm * 256 + r) * 1024 + u.pn * 128 + c); return d; }
    __device__ __forceinline__ void store2(const Unit& u, int r, int c, f32x4 g, f32x4 up, const Data& d, const Col& q) const {
        const int row = u.pm * 256 + r, col = u.pn * 128 + c; f32x4 a1, b;
        const float xv[4] = {bflo(d.xw.x), bfhi(d.xw.x), bflo(d.xw.y), bfhi(d.xw.y)};
#pragma unroll
        for (int j = 0; j < 4; ++j) { const float rr = sigmoidf_(g[j] + q.ba4[j]), ii = sigmoidf_(up[j] + q.bx4[j]);
            const float aa = __expf(-rr * q.sp4[j]); a1[j] = 1.0f - aa; b[j] = sqrtf(fmaxf(1.0f - aa * aa, 0.f)) * (ii * xv[j]); }
        u32x2 wa, wb; wa.x = pk2(a1[0], a1[1]); wa.y = pk2(a1[2], a1[3]); wb.x = pk2(b[0], b[1]); wb.y = pk2(b[2], b[3]);
        *(u32x2*)(la + (size_t)row * 1024 + col) = wa; *(u32x2*)(lb + (size_t)row * 1024 + col) = wb; }
    __device__ __forceinline__ void store2(const Unit& u, int r, int c, f32x4 g, f32x4 up) const { store2(u, r, c, g, up, load(u, r, c), cload(u, c)); } };
struct EpiBranch { static constexpr bool DUAL = false, PRELOAD = true; const bf16* proj; bf16* mf; bf16* mg;
    struct Data { u32x2 gw, pw; }; typedef EpiNoCol Col;
    __device__ __forceinline__ Col cload(const Unit&, int) const { return Col{}; }
    __device__ __forceinline__ Data load(const Unit& u, int r, int c) const { const int row = u.pm * 256 + r, col = u.pn * 256 + c; Data d;
        d.gw = *(const u32x2*)(proj + (size_t)row * PROJ_N + PX_GATE + u.g * 2048 + col); d.pw = (u32x2){0u, 0u}; if (u.g != 0) d.pw = *(const u32x2*)(mf + (size_t)row * D + col); return d; }
    __device__ __forceinline__ void store(const Unit& u, int r, int c, f32x4 v, const Data& d, const Col&) const {
        const int row = u.pm * 256 + r, col = u.pn * 256 + c;
        f32x4 o; o[0] = v[0] * sigmoidf_(bflo(d.gw.x)) + bflo(d.pw.x); o[1] = v[1] * sigmoidf_(bfhi(d.gw.x)) + bfhi(d.pw.x); o[2] = v[2] * sigmoidf_(bflo(d.gw.y)) + bflo(d.pw.y); o[3] = v[3] * sigmoidf_(bfhi(d.gw.y)) + bfhi(d.pw.y);
        u32x2 w; w.x = pk2(o[0], o[1]); w.y = pk2(o[2], o[3]);
        *(u32x2*)((u.g == 2 ? mg : mf) + (size_t)row * D + col) = w; }
    __device__ __forceinline__ void store(const Unit& u, int r, int c, f32x4 v) const { store(u, r, c, v, load(u, r, c), Col{}); } };
template <bool BIN, bool BOUT> struct EpiResidT { static constexpr bool DUAL = false, PRELOAD = true; const void* base; void* out; int ldc; float sc;
    struct Data { f32x4 bv; }; typedef EpiNoCol Col;
    __device__ __forceinline__ Col cload(const Unit&, int) const { return Col{}; }
    __device__ __forceinline__ Data load(const Unit& u, int r, int c) const { const size_t o = (size_t)(u.pm * 256 + r) * ldc + u.pn * 256 + c; Data d;
        if (BIN) { const u32x2 w = *(const u32x2*)((const bf16*)base + o); d.bv = (f32x4){bflo(w.x), bfhi(w.x), bflo(w.y), bfhi(w.y)}; } else d.bv = *(const f32x4*)((const float*)base + o); return d; }
    __device__ __forceinline__ void store(const Unit& u, int r, int c, f32x4 v, const Data& d, const Col&) const {
        const size_t o = (size_t)(u.pm * 256 + r) * ldc + u.pn * 256 + c; const f32x4 y = d.bv + v * sc;
        if (BOUT) { u32x2 w; w.x = pk2(y[0], y[1]); w.y = pk2(y[2], y[3]); *(u32x2*)((bf16*)out + o) = w; } else *(f32x4*)((float*)out + o) = y; }
    __device__ __forceinline__ void store(const Unit& u, int r, int c, f32x4 v) const { store(u, r, c, v, load(u, r, c), Col{}); } };
struct EpiSwiglu { static constexpr bool DUAL = true, PRELOAD = false; bf16* O; int ldo;
    __device__ __forceinline__ void store2(const Unit& u, int r, int c, f32x4 g, f32x4 up) const {
        f32x4 o;
#pragma unroll
        for (int j = 0; j < 4; ++j) o[j] = g[j] * sigmoidf_(g[j]) * up[j];
        u32x2 w; w.x = pk2(o[0], o[1]); w.y = pk2(o[2], o[3]); *(u32x2*)(O + (size_t)(u.pm * 256 + r) * ldo + u.pn * 128 + c) = w; } };
struct EpiSwigluF8 { static constexpr bool DUAL = true, PRELOAD = false; unsigned char* O; int ldo; float sin;
    __device__ __forceinline__ void store2(const Unit& u, int r, int c, f32x4 g, f32x4 up) const {
        f32x4 o;
#pragma unroll
        for (int j = 0; j < 4; ++j) { const float gg = g[j] * sin, uu = up[j] * sin; o[j] = gg * sigmoidf_(gg) * uu * F8_HSCALE; }
        *(unsigned*)(O + (size_t)(u.pm * 256 + r) * ldo + u.pn * 128 + c) = pk4_fp8(o[0], o[1], o[2], o[3]); } };
struct EpiScaleRow { static constexpr bool DUAL = false, PRELOAD = true; bf16* ys; const float* rowg; float sc;
    struct Data { float g; }; typedef EpiNoCol Col;
    __device__ __forceinline__ Col cload(const Unit&, int) const { return Col{}; }
    __device__ __forceinline__ Data load(const Unit& u, int r, int) const { Data d; d.g = rowg[u.pm * 256 + r]; return d; }
    __device__ __forceinline__ void store(const Unit& u, int r, int c, f32x4 v, const Data& d, const Col&) const {
        const int row = u.pm * 256 + r; const float gs = d.g * sc; u32x2 w; w.x = pk2(v[0] * gs, v[1] * gs); w.y = pk2(v[2] * gs, v[3] * gs);
        *(u32x2*)(ys + (size_t)u.k * MOE_ROWS * D + (size_t)row * D + u.pn * 256 + c) = w; }
    __device__ __forceinline__ void store(const Unit& u, int r, int c, f32x4 v) const { store(u, r, c, v, load(u, r, c), Col{}); } };
template <bool BOUT> struct EpiPleT { static constexpr bool DUAL = false, PRELOAD = true; const bf16* hin; void* hout; const bf16* pp;
    struct Data { u32x2 pw, hw; }; typedef EpiNoCol Col;
    __device__ __forceinline__ Col cload(const Unit&, int) const { return Col{}; }
    __device__ __forceinline__ Data load(const Unit& u, int r, int c) const { const size_t o = (size_t)(u.pm * 256 + r) * D + u.pn * 256 + c; Data d; d.pw = *(const u32x2*)(pp + o); d.hw = *(const u32x2*)(hin + o); return d; }
    __device__ __forceinline__ void store(const Unit& u, int r, int c, f32x4 v, const Data& d, const Col&) const {
        const size_t o = (size_t)(u.pm * 256 + r) * D + u.pn * 256 + c;
        f32x4 y; y[0] = bflo(d.hw.x) + bflo(d.pw.x) * sigmoidf_(v[0]); y[1] = bfhi(d.hw.x) + bfhi(d.pw.x) * sigmoidf_(v[1]); y[2] = bflo(d.hw.y) + bflo(d.pw.y) * sigmoidf_(v[2]); y[3] = bfhi(d.hw.y) + bfhi(d.pw.y) * sigmoidf_(v[3]);
        if (BOUT) { u32x2 w; w.x = pk2(y[0], y[1]); w.y = pk2(y[2], y[3]); *(u32x2*)((bf16*)hout + o) = w; } else *(f32x4*)((float*)hout + o) = y; }
    __device__ __forceinline__ void store(const Unit& u, int r, int c, f32x4 v) const { store(u, r, c, v, load(u, r, c), Col{}); } };

template <class Epi, class Sched>
__device__ __forceinline__ void gemm_naive(LAS unsigned char* lds, int tid, const Sched& S, const Epi& E) {
    LAS float* As = (LAS float*)lds;
    LAS float* Bs = (LAS float*)(lds + 4096);
    const int tx = tid & 31, ty = tid >> 5;
    const int lrow = tid >> 1, lk = (tid & 1) * 8;
    Unit u;
    for (int i = 0; S.next(i, u); ++i) {
        const bf16* A0 = (const bf16*)S.aptr(u); const bf16* B0 = (const bf16*)S.bptr(u);
        for (int rc = 0; rc < 4; ++rc) {
            f32x4 lo[4], hi[4];
#pragma unroll
            for (int q = 0; q < 4; ++q) { lo[q] = (f32x4){0.f, 0.f, 0.f, 0.f}; hi[q] = (f32x4){0.f, 0.f, 0.f, 0.f}; }
            for (int k0 = 0; k0 < S.K; k0 += 16) {
                __syncthreads();
                { const u32x4 bv = *(const u32x4*)(B0 + (size_t)lrow * S.ldb + k0 + lk);
                  const float f[8] = {bflo(bv.x), bfhi(bv.x), bflo(bv.y), bfhi(bv.y), bflo(bv.z), bfhi(bv.z), bflo(bv.w), bfhi(bv.w)};
#pragma unroll
                  for (int j = 0; j < 8; ++j) Bs[(lk + j) * 256 + lrow] = f[j]; }
                if (tid < 128) { const u32x4 av = *(const u32x4*)(A0 + (size_t)(rc * 64 + lrow) * S.lda + k0 + lk);
                  const float f[8] = {bflo(av.x), bfhi(av.x), bflo(av.y), bfhi(av.y), bflo(av.z), bfhi(av.z), bflo(av.w), bfhi(av.w)};
#pragma unroll
                  for (int j = 0; j < 8; ++j) As[(lk + j) * 64 + lrow] = f[j]; }
                __syncthreads();
#pragma unroll
                for (int k = 0; k < 16; ++k) {
                    const f32x4 a = *(const LAS f32x4*)(As + k * 64 + 4 * ty), b0 = *(const LAS f32x4*)(Bs + k * 256 + 4 * tx), b1 = *(const LAS f32x4*)(Bs + k * 256 + 128 + 4 * tx);
#pragma unroll
                    for (int q = 0; q < 4; ++q) { lo[q] += b0 * a[q]; hi[q] += b1 * a[q]; }
                }
            }
#pragma unroll
            for (int q = 0; q < 4; ++q) { const int r = rc * 64 + 4 * ty + q;
                if constexpr (Epi::DUAL) E.store2(u, r, 4 * tx, lo[q], hi[q]);
                else { E.store(u, r, 4 * tx, lo[q]); E.store(u, r, 128 + 4 * tx, hi[q]); } }
        }
    }
    __syncthreads();
}

namespace pg8 {
constexpr int BK = 64, HALF = 128, HTB = HALF * BK * 2;
__device__ __forceinline__ int lds_byte(int r, int c) { const int st = (r >> 4) * 2 + (c >> 5), rr = r & 15, cc = c & 31, ob = rr * 64 + cc * 2; return st * 1024 + (ob ^ (((ob >> 9) & 1) << 5)); }
__device__ __forceinline__ void stage_rc(int b, int& R, int& C) { const int st = b / 1024, sb = b % 1024, swz = sb ^ (((sb >> 9) & 1) << 5); R = (st >> 1) * 16 + swz / 64; C = (st & 1) * 32 + (swz % 64) / 2; }
template <class Epi, class Sched, bool FP8 = false>
__device__ __forceinline__ void gemm_phase(LAS unsigned char* lds, int tid, const Sched& S, const Epi& E) {
    const int wid = __builtin_amdgcn_readfirstlane(tid >> 6), lane = tid & 63, wr = wid >> 2, wc = wid & 3, fr = lane & 15, fq = lane >> 4;
    const int nt = S.K / BK;
    unsigned voffA[2], voffB[2];
#pragma unroll
    for (int i = 0; i < 2; ++i) { int R, Cc; stage_rc(tid * 16 + i * 8192, R, Cc); const int rho = R & 31, Rb = (R & ~31) + 8 * ((rho & 15) >> 2) + 4 * (rho >> 4) + (rho & 3);
        voffA[i] = (unsigned)(R * S.lda + Cc) * 2u; voffB[i] = (unsigned)(Rb * S.ldb + Cc) * 2u; }
    const size_t kstep = (size_t)(BK * 2);
    const size_t hstepA = (size_t)HALF * S.lda * 2, hstepB = (size_t)HALF * S.ldb * 2;
    const unsigned ldsw = (unsigned)wid * 1024u;
    const int aoff = lds_byte(wr * 64 + fr, fq * 8), boff = lds_byte(wc * 32 + fr, fq * 8);
#define PG8_SA(b, h) (((b) * 2 + (h)) * HTB)
#define PG8_SB(b, h) ((4 + (b) * 2 + (h)) * HTB)
#define PG8_STAGE(bufoff, gbase, voff) do { _Pragma("unroll") for (int _i = 0; _i < 2; ++_i) \
        __builtin_amdgcn_global_load_lds((const unsigned*)((const char*)(gbase) + (voff)[_i]), (LAS unsigned*)(lds + (bufoff) + ldsw + _i * 8192), 16, 0, 0); } while (0)
#define PG8_LDA(dst, b, h) do { _Pragma("unroll") for (int m = 0; m < 4; ++m) _Pragma("unroll") for (int k = 0; k < 2; ++k) dst[m][k] = *(const LAS bf16x8*)(lds + PG8_SA(b, h) + aoff + m * 2048 + k * 1024); } while (0)
#define PG8_LDB(dst, b, h) do { _Pragma("unroll") for (int n = 0; n < 2; ++n) _Pragma("unroll") for (int k = 0; k < 2; ++k) dst[n][k] = *(const LAS bf16x8*)(lds + PG8_SB(b, h) + boff + n * 2048 + k * 1024); } while (0)
#define PG8_MMA(ai, bj, At, Bt) do { __builtin_amdgcn_s_setprio(1); _Pragma("unroll") for (int m = 0; m < 4; ++m) _Pragma("unroll") for (int n = 0; n < 2; ++n) { \
        if constexpr (FP8) { typedef int v8i_ __attribute__((ext_vector_type(8))); typedef int v4i_ __attribute__((ext_vector_type(4))); \
            const v4i_ b0_ = __builtin_bit_cast(v4i_, Bt[n][0]), b1_ = __builtin_bit_cast(v4i_, Bt[n][1]), a0_ = __builtin_bit_cast(v4i_, At[m][0]), a1_ = __builtin_bit_cast(v4i_, At[m][1]); \
            const v8i_ bb_ = {b0_[0], b0_[1], b0_[2], b0_[3], b1_[0], b1_[1], b1_[2], b1_[3]}, aa_ = {a0_[0], a0_[1], a0_[2], a0_[3], a1_[0], a1_[1], a1_[2], a1_[3]}; \
            asm volatile("v_mfma_scale_f32_16x16x128_f8f6f4 %0, %1, %2, %0, %3, %3 op_sel_hi:[0,0,0]" : "+v"(acc[ai][bj][m][n]) : "v"(bb_), "v"(aa_), "v"(f8scale)); } \
        else { _Pragma("unroll") for (int k = 0; k < 2; ++k) acc[ai][bj][m][n] = __builtin_amdgcn_mfma_f32_16x16x32_bf16(Bt[n][k], At[m][k], acc[ai][bj][m][n], 0, 0, 0); } } \
        __builtin_amdgcn_s_setprio(0); } while (0)
#define PG8_WAIT_V(n) asm volatile("s_waitcnt vmcnt(" #n ")" ::: "memory")
#define PG8_WAIT_L(n) asm volatile("s_waitcnt lgkmcnt(" #n ")" ::: "memory")
#define PG8_BAR __builtin_amdgcn_s_barrier()
#define PG8_SCHED __builtin_amdgcn_sched_barrier(0)
    Unit cur, nxt; int ui = 0;
    if (!S.next(0, cur)) return;
    f32x4 acc[2][2][4][2];
#pragma unroll
    for (int a = 0; a < 2; ++a)
#pragma unroll
        for (int b = 0; b < 2; ++b)
#pragma unroll
            for (int m = 0; m < 4; ++m)
#pragma unroll
                for (int n = 0; n < 2; ++n) acc[a][b][m][n] = (f32x4){0.f, 0.f, 0.f, 0.f};
    bf16x8 At[4][2], B0[2][2], B1[2][2];
    const int f8scale = 0x7f7f7f7f; (void)f8scale;
    const char* cA = S.aptr(cur); const char* cB = S.bptr(cur);
    PG8_STAGE(PG8_SB(0, 0), cB, voffB); PG8_STAGE(PG8_SB(0, 1), cB + hstepB, voffB); PG8_STAGE(PG8_SA(0, 0), cA, voffA); PG8_STAGE(PG8_SA(0, 1), cA + hstepA, voffA);
    if (wr == 1) PG8_BAR;
    PG8_WAIT_V(2); PG8_BAR;
    PG8_STAGE(PG8_SB(1, 0), cB + kstep, voffB); PG8_STAGE(PG8_SA(1, 0), cA + kstep, voffA); PG8_STAGE(PG8_SB(1, 1), cB + hstepB + kstep, voffB);
    PG8_WAIT_V(6); PG8_BAR;
    for (;;) {
        const bool has_next = S.next(ui + 1, nxt);
        const char* nA = has_next ? S.aptr(nxt) : cA; const char* nB = has_next ? S.bptr(nxt) : cB;
        for (int t = 0; t < nt; t += 2) {
            const bool last = (t == nt - 2);
            const char* a1 = cA + (size_t)(t + 1) * kstep;
            const char* a2 = last ? nA : cA + (size_t)(t + 2) * kstep; const char* b2 = last ? nB : cB + (size_t)(t + 2) * kstep;
            const char* a3 = a2 + kstep; const char* b3 = b2 + kstep;
            PG8_LDB(B0, 0, 0); PG8_LDB(B1, 0, 1); PG8_SCHED; PG8_LDA(At, 0, 0); PG8_STAGE(PG8_SA(1, 1), a1 + hstepA, voffA);
            PG8_WAIT_V(8); PG8_WAIT_L(0); PG8_BAR; PG8_MMA(0, 0, At, B0); PG8_MMA(0, 1, At, B1); PG8_BAR; PG8_SCHED;
            PG8_LDA(At, 0, 1); PG8_STAGE(PG8_SB(0, 0), b2, voffB); PG8_STAGE(PG8_SB(0, 1), b2 + hstepB, voffB); PG8_STAGE(PG8_SA(0, 0), a2, voffA);
            PG8_WAIT_V(8); PG8_WAIT_L(0); PG8_BAR; PG8_MMA(1, 0, At, B0); PG8_MMA(1, 1, At, B1); PG8_BAR; PG8_SCHED;
            PG8_LDB(B0, 1, 0); PG8_LDB(B1, 1, 1); PG8_SCHED; PG8_LDA(At, 1, 0); PG8_STAGE(PG8_SA(0, 1), a2 + hstepA, voffA);
            PG8_WAIT_V(8); PG8_WAIT_L(0); PG8_BAR; PG8_MMA(0, 0, At, B0); PG8_MMA(0, 1, At, B1); PG8_BAR; PG8_SCHED;
            PG8_LDA(At, 1, 1); PG8_STAGE(PG8_SB(1, 0), b3, voffB); PG8_STAGE(PG8_SB(1, 1), b3 + hstepB, voffB); PG8_STAGE(PG8_SA(1, 0), a3, voffA);
            PG8_WAIT_V(8); PG8_WAIT_L(0); PG8_BAR; PG8_MMA(1, 0, At, B0); PG8_MMA(1, 1, At, B1); PG8_BAR; PG8_SCHED;
        }
        if (wr == 0) PG8_BAR;
        if constexpr (FP8) asm volatile("s_nop 15\n\ts_nop 15" ::: "memory");
        Unit eu; eu.pm = __builtin_amdgcn_readfirstlane(cur.pm); eu.pn = __builtin_amdgcn_readfirstlane(cur.pn); eu.g = __builtin_amdgcn_readfirstlane(cur.g); eu.k = __builtin_amdgcn_readfirstlane(cur.k); asm volatile("" : "+s"(eu.pm), "+s"(eu.pn), "+s"(eu.g), "+s"(eu.k));
        if constexpr (Epi::PRELOAD) {
            typename Epi::Col cv[2];
#pragma unroll
            for (int n = 0; n < 2; ++n) cv[n] = E.cload(eu, wc * 32 + 8 * fq + 4 * n);
            constexpr int NB = Epi::DUAL ? 2 : 4;
            typename Epi::Data dd[2][8];
#define PG8_EPI_LOAD(b_, slot_) do { _Pragma("unroll") for (int j_ = 0; j_ < 8; ++j_) { int ai_, m_, bj_, n_; \
                if constexpr (Epi::DUAL) { ai_ = (b_); m_ = j_ >> 1; bj_ = 0; n_ = j_ & 1; } else { ai_ = (b_) >> 1; m_ = 2 * ((b_) & 1) + (j_ >> 2); bj_ = (j_ >> 1) & 1; n_ = j_ & 1; } \
                dd[slot_][j_] = E.load(eu, ai_ * 128 + wr * 64 + m_ * 16 + fr, bj_ * 128 + wc * 32 + 8 * fq + 4 * n_); } } while (0)
            PG8_EPI_LOAD(0, 0);
#pragma unroll
            for (int b = 0; b < NB; ++b) {
                if (b + 1 < NB) PG8_EPI_LOAD(b + 1, (b + 1) & 1);
#pragma unroll
                for (int j = 0; j < 8; ++j) { int ai, m, bj, n;
                    if constexpr (Epi::DUAL) { ai = b; m = j >> 1; bj = 0; n = j & 1; } else { ai = b >> 1; m = 2 * (b & 1) + (j >> 2); bj = (j >> 1) & 1; n = j & 1; }
                    const int r = ai * 128 + wr * 64 + m * 16 + fr, c = wc * 32 + 8 * fq + 4 * n;
                    if constexpr (Epi::DUAL) E.store2(eu, r, c, acc[ai][0][m][n], acc[ai][1][m][n], dd[b & 1][j], cv[n]);
                    else E.store(eu, r, bj * 128 + c, acc[ai][bj][m][n], dd[b & 1][j], cv[n]); }
            }
#undef PG8_EPI_LOAD
        } else {
#pragma unroll
        for (int ai = 0; ai < 2; ++ai)
#pragma unroll
            for (int m = 0; m < 4; ++m) { const int r = ai * 128 + wr * 64 + m * 16 + fr;
                if constexpr (Epi::DUAL) {
#pragma unroll
                    for (int n = 0; n < 2; ++n) E.store2(eu, r, wc * 32 + 8 * fq + 4 * n, acc[ai][0][m][n], acc[ai][1][m][n]);
                } else {
#pragma unroll
                    for (int bj = 0; bj < 2; ++bj)
#pragma unroll
                        for (int n = 0; n < 2; ++n) E.store(eu, r, bj * 128 + wc * 32 + 8 * fq + 4 * n, acc[ai][bj][m][n]); } }
        }
        if (!has_next) break;
#pragma unroll
        for (int a = 0; a < 2; ++a)
#pragma unroll
            for (int b = 0; b < 2; ++b)
#pragma unroll
                for (int m = 0; m < 4; ++m)
#pragma unroll
                    for (int n = 0; n < 2; ++n) acc[a][b][m][n] = (f32x4){0.f, 0.f, 0.f, 0.f};
        cur = nxt; cA = nA; cB = nB; ++ui;
        if (wr == 1) PG8_BAR;
    }
    PG8_WAIT_V(0);
    PG8_BAR;
#undef PG8_SA
#undef PG8_SB
#undef PG8_STAGE
#undef PG8_LDA
#undef PG8_LDB
#undef PG8_MMA
#undef PG8_WAIT_V
#undef PG8_WAIT_L
#undef PG8_BAR
#undef PG8_SCHED
}
}

template <class Epi, class Sched>
__device__ __forceinline__ void gemm_run_fp8(Ctx& C, const Sched& S, const Epi& E) { pg8::gemm_phase<Epi, Sched, true>(C.lds, C.tid, S, E); }
template <class Epi, class Sched>
__device__ __forceinline__ void gemm_run(Ctx& C, const Sched& S, const Epi& E) {
#if FAST_GEMM
    pg8::gemm_phase<Epi, Sched>(C.lds, C.tid, S, E);
#else
    gemm_naive<Epi, Sched>(C.lds, C.tid, S, E);
#endif
}

__device__ __forceinline__ int win_col(int n) {
    if (n < 6144) return n;
    if (n < 6912) return 6224 + (n - 6144);
    if (n < 7424) return 6992 + (n - 6912);
    if (n < 7488) return 6144 + (n - 7424);
    if (n < 7552) return 7504 + (n - 7488);
    if (n < 7568) return 6208 + (n - 7552);
    if (n < 7680) return -1;
    return 7568 + (n - 7680);
}
struct RsPlain { const float* s; __device__ __forceinline__ const float* operator()(int n) const { return s + n; } };
struct RsWin { const float* s; __device__ __forceinline__ const float* operator()(int n) const { const int c = win_col(n); return c < 0 ? nullptr : s + c; } };
struct RsGU { const float* g; ptrdiff_t du; __device__ __forceinline__ const float* operator()(int n) const { const int tile = n >> 8, r = n & 255; return g + (r < 128 ? (ptrdiff_t)0 : du) + tile * 128 + (r & 127); } };
template <class RS>
__device__ __forceinline__ void conv_job(Ctx& C, bf16* dst, int nrows, int K, int srcN, const RS& rs) {
#if FAST_CONV
    LAS unsigned char* tile = C.lds;
    const int nkb = K / 64, nitems = (nrows / 256) * nkb, w = C.wave, L = C.lane, tid = C.tid;
    f32x4 v[8], vn[8]; float zf = 1.f, zfn = 1.f;
#define CJ_LOAD(it_, dst_, z_) do { const int nb_ = (it_) / nkb, kb_ = (it_) % nkb; const float* sp_ = rs(nb_ * 256 + 4 * L); z_ = sp_ ? 1.f : 0.f; sp_ = sp_ ? sp_ : rs(0); \
        _Pragma("unroll") for (int j = 0; j < 8; ++j) dst_[j] = __builtin_nontemporal_load((const f32x4*)(sp_ + (size_t)(kb_ * 64 + 8 * w + j) * srcN)); } while (0)
#define CJ_PROC(it_, src_, z_) do { const int nb_ = (it_) / nkb, kb_ = (it_) % nkb, n0_ = nb_ * 256, k0_ = kb_ * 64; \
        asm volatile("s_waitcnt lgkmcnt(0)" ::: "memory"); __builtin_amdgcn_s_barrier();     \
        _Pragma("unroll") for (int q = 0; q < 4; ++q) { u32x4 o; o.x = pk2(src_[0][q] * z_, src_[1][q] * z_); o.y = pk2(src_[2][q] * z_, src_[3][q] * z_); o.z = pk2(src_[4][q] * z_, src_[5][q] * z_); o.w = pk2(src_[6][q] * z_, src_[7][q] * z_); \
            *(LAS u32x4*)(tile + (4 * L + q) * 144 + w * 16) = o; } \
        asm volatile("s_waitcnt lgkmcnt(0)" ::: "memory"); __builtin_amdgcn_s_barrier(); \
        _Pragma("unroll") for (int i = 0; i < 4; ++i) { const int idx = tid + 512 * i, n = idx >> 3, ch = idx & 7; const u32x4 o = *(const LAS u32x4*)(tile + n * 144 + ch * 16); *(u32x4*)(dst + (size_t)(n0_ + n) * K + k0_ + ch * 8) = o; } } while (0)
    int it = C.bid;
    if (it < nitems) {
        CJ_LOAD(it, v, zf);
        for (;;) {
            { const int nx = it + C.G, nc = nx < nitems ? nx : nitems - 1; CJ_LOAD(nc, vn, zfn); CJ_PROC(it, v, zf); it = nx; if (it >= nitems) break; }
            { const int nx = it + C.G, nc = nx < nitems ? nx : nitems - 1; CJ_LOAD(nc, v, zf); CJ_PROC(it, vn, zfn); it = nx; if (it >= nitems) break; }
        }
    }
#undef CJ_LOAD
#undef CJ_PROC
    __syncthreads();
#else
    const size_t tot = (size_t)nrows * K, gsz = (size_t)C.G * 512;
    for (size_t i = (size_t)C.bid * 512 + C.tid; i < tot; i += gsz) { const int k = (int)(i / nrows), n = (int)(i % nrows); const float* sp = rs(n);
        dst[(size_t)n * K + k] = sp ? f2bf(sp[(size_t)k * srcN]) : (bf16)0; }
#endif
}

template <class RS>
__device__ __forceinline__ void conv_job_fp8(Ctx& C, unsigned char* dst, int nrows, int K, int srcN, const RS& rs, float scale) {
    LAS unsigned char* tile = C.lds;
    const int nkb = K / 128, nitems = (nrows / 256) * nkb, w = C.wave, L = C.lane, tid = C.tid;
    f32x4 v[16], vn[16];
#define CJ_LOAD8(it_, dst_) do { const int nb_ = (it_) / nkb, kb_ = (it_) % nkb; const float* sp_ = rs(nb_ * 256 + 4 * L); _Pragma("unroll") for (int j = 0; j < 16; ++j) \
        dst_[j] = __builtin_nontemporal_load((const f32x4*)(sp_ + (size_t)(kb_ * 128 + 16 * w + j) * srcN)); } while (0)
#define CJ_PROC8(it_, src_) do { const int nb_ = (it_) / nkb, kb_ = (it_) % nkb, n0_ = nb_ * 256, k0_ = kb_ * 128; \
        asm volatile("s_waitcnt lgkmcnt(0)" ::: "memory"); __builtin_amdgcn_s_barrier(); \
        _Pragma("unroll") for (int q = 0; q < 4; ++q) { u32x4 o; o.x = pk4_fp8(src_[0][q] * scale, src_[1][q] * scale, src_[2][q] * scale, src_[3][q] * scale); o.y = pk4_fp8(src_[4][q] * scale, src_[5][q] * scale, src_[6][q] * scale, src_[7][q] * scale); \
            o.z = pk4_fp8(src_[8][q] * scale, src_[9][q] * scale, src_[10][q] * scale, src_[11][q] * scale); o.w = pk4_fp8(src_[12][q] * scale, src_[13][q] * scale, src_[14][q] * scale, src_[15][q] * scale); \
            *(LAS u32x4*)(tile + (4 * L + q) * 144 + w * 16) = o; } \
        asm volatile("s_waitcnt lgkmcnt(0)" ::: "memory"); __builtin_amdgcn_s_barrier(); \
        _Pragma("unroll") for (int i = 0; i < 4; ++i) { const int idx = tid + 512 * i, n = idx >> 3, ch = idx & 7; const u32x4 o = *(const LAS u32x4*)(tile + n * 144 + ch * 16); *(u32x4*)(dst + (size_t)(n0_ + n) * K + k0_ + ch * 16) = o; } } while (0)
    int it = C.bid;
    if (it < nitems) {
        CJ_LOAD8(it, v);
        for (;;) {
            { const int nx = it + C.G, nc = nx < nitems ? nx : nitems - 1; CJ_LOAD8(nc, vn); CJ_PROC8(it, v); it = nx; if (it >= nitems) break; }
            { const int nx = it + C.G, nc = nx < nitems ? nx : nitems - 1; CJ_LOAD8(nc, v); CJ_PROC8(it, vn); it = nx; if (it >= nitems) break; }
        }
    }
#undef CJ_LOAD8
#undef CJ_PROC8
    __syncthreads();
}

template <bool ROUTER, int OUT8 = 0, bool SRC16 = true>
__device__ __forceinline__ void rmsnorm_rows(Ctx& C, const void* src, const float* gain, bf16* dst, const float* router, int* toke, float* tokg, unsigned char* dst8 = nullptr) {
    const int gw = C.bid * 8 + C.wave, NGW = C.G * 8, lane = C.lane;
    for (int m = gw; m < M; m += NGW) {
        f32x4 v[8]; float ss = 0.f;
#pragma unroll
        for (int j = 0; j < 8; ++j) { if (SRC16) { const u32x2 w = ((const u32x2*)((const bf16*)src + (size_t)m * D))[lane + 64 * j]; v[j] = (f32x4){bflo(w.x), bfhi(w.x), bflo(w.y), bfhi(w.y)}; } else v[j] = ((const f32x4*)((const float*)src + (size_t)m * D))[lane + 64 * j];
            ss += (v[j][0] * v[j][0] + v[j][1] * v[j][1]) + (v[j][2] * v[j][2] + v[j][3] * v[j][3]); }
        const float rstd = 1.0f / sqrtf(wave_sum(ss) * (1.0f / D) + EPS);
        float lg[8];
        if (ROUTER) {
#pragma unroll
            for (int e = 0; e < 8; ++e) lg[e] = 0.f; }
#pragma unroll
        for (int j = 0; j < 8; ++j) { const f32x4 g4 = ((const f32x4*)gain)[lane + 64 * j]; const f32x4 y = v[j] * rstd * g4;
            if (OUT8 == 1) { *(unsigned*)((unsigned char*)dst + (size_t)m * D + 4 * (lane + 64 * j)) = pk4_fp8(y[0] * F8_XSCALE, y[1] * F8_XSCALE, y[2] * F8_XSCALE, y[3] * F8_XSCALE); }
            else { u32x2 w; w.x = pk2(y[0], y[1]); w.y = pk2(y[2], y[3]); *(u32x2*)(dst + (size_t)m * D + 4 * (lane + 64 * j)) = w;
                if (OUT8 == 2) *(unsigned*)(dst8 + (size_t)m * D + 4 * (lane + 64 * j)) = pk4_fp8(y[0] * F8_XSCALE, y[1] * F8_XSCALE, y[2] * F8_XSCALE, y[3] * F8_XSCALE); }
            if (ROUTER) {
#pragma unroll
                for (int q = 0; q < 4; ++q) { const f32x4* rp = (const f32x4*)(router + (size_t)(4 * (lane + 64 * j) + q) * 8); const f32x4 r0 = rp[0], r1 = rp[1];
                    lg[0] += y[q] * r0[0]; lg[1] += y[q] * r0[1]; lg[2] += y[q] * r0[2]; lg[3] += y[q] * r0[3]; lg[4] += y[q] * r1[0]; lg[5] += y[q] * r1[1]; lg[6] += y[q] * r1[2]; lg[7] += y[q] * r1[3]; } } }
        if (ROUTER) {
#pragma unroll
            for (int e = 0; e < 8; ++e) lg[e] = wave_sum(lg[e]);
            int e0 = 0; float v0 = lg[0];
#pragma unroll
            for (int e = 1; e < 8; ++e) if (lg[e] > v0) { v0 = lg[e]; e0 = e; }
            int e1 = -1; float v1 = -INFINITY;
#pragma unroll
            for (int e = 0; e < 8; ++e) if (e != e0 && lg[e] > v1) { v1 = lg[e]; e1 = e; }
            const float g1 = 1.0f / (1.0f + __expf(v0 - v1)), g0 = 1.0f - g1;
            if (lane == 0) { toke[2 * m] = e0; toke[2 * m + 1] = e1; tokg[2 * m] = g0; tokg[2 * m + 1] = g1; }
        }
    }
}

__device__ __forceinline__ void rope_sc(float posf, int i, int d, float& sn, float& cs) {
    const float invf = exp2f(-(float)i * (2.0f / (float)d) * LOG2_THETA); const float rev = posf * invf * INV_2PI; const float fr = rev - floorf(rev);
    sn = __builtin_amdgcn_sinf(fr); cs = __builtin_amdgcn_cosf(fr);
}
__device__ __forceinline__ void postproj_tokens(Ctx& C, const bf16* proj, const int* pos, const float* convw, const float* convb, const float* gq, const float* gk, const float* qan, const float* kvan,
                                                bf16* xc, bf16* qs, bf16* ks, bf16* qi, bf16* ki, bf16* cqn, bf16* ckvn) {
    const int gw = C.bid * 8 + C.wave, NGW = C.G * 8, lane = C.lane;
    const float QSCALE = 0.08838834764831845f;
    for (int m = gw; m < M; m += NGW) {
        const int t = m & (T - 1); const bf16* pr = proj + (size_t)m * PROJ_N; const float posf = (float)pos[m];
#pragma unroll
        for (int half = 0; half < 2; ++half) { const int c0 = half * 512 + lane * 8; float a[8];
#pragma unroll
            for (int i = 0; i < 8; ++i) a[i] = convb[c0 + i];
#pragma unroll
            for (int j = 0; j < 4; ++j) { if (t - 3 + j >= 0) { const u32x4 xv = *(const u32x4*)(pr - (ptrdiff_t)(3 - j) * PROJ_N + PX_LRUX + c0); const float* w = convw + j * 1024 + c0;
                a[0] += w[0] * bflo(xv.x); a[1] += w[1] * bfhi(xv.x); a[2] += w[2] * bflo(xv.y); a[3] += w[3] * bfhi(xv.y); a[4] += w[4] * bflo(xv.z); a[5] += w[5] * bfhi(xv.z); a[6] += w[6] * bflo(xv.w); a[7] += w[7] * bfhi(xv.w); } }
            u32x4 o; o.x = pk2(a[0], a[1]); o.y = pk2(a[2], a[3]); o.z = pk2(a[4], a[5]); o.w = pk2(a[6], a[7]); *(u32x4*)(xc + (size_t)m * 1024 + c0) = o; }
        { float sn, cs; rope_sc(posf, lane, 128, sn, cs);
#pragma unroll
          for (int h = 0; h < 8; ++h) {
#pragma unroll
            for (int which = 0; which < 2; ++which) { const int base = (which ? PX_AK : PX_AQ) + h * 128; const float* gg = which ? gk : gq;
                const float x1 = bf2f(pr[base + lane]), x2 = bf2f(pr[base + 64 + lane]); const float rstd = 1.0f / sqrtf(wave_sum(x1 * x1 + x2 * x2) * (1.0f / 128.0f) + EPS);
                const float y1 = x1 * rstd * gg[lane], y2 = x2 * rstd * gg[64 + lane]; const float sc = which ? 1.0f : QSCALE;
                bf16* o = (which ? ks : qs) + (size_t)m * 1024 + h * 128; o[lane] = f2bf((y1 * cs - y2 * sn) * sc); o[64 + lane] = f2bf((y2 * cs + y1 * sn) * sc); } } }
        { const int i = lane & 31; float sn, cs; rope_sc(posf, i, 64, sn, cs);
#pragma unroll
          for (int hh = 0; hh < 8; ++hh) { const int head = 2 * hh + (lane >> 5), base = PX_IQ + head * 64; const float x1 = bf2f(pr[base + i]), x2 = bf2f(pr[base + 32 + i]);
              bf16* o = qi + (size_t)m * 1024 + head * 64; o[i] = f2bf(x1 * cs - x2 * sn); o[32 + i] = f2bf(x2 * cs + x1 * sn); }
          if (lane < 32) { const float x1 = bf2f(pr[PX_IK + i]), x2 = bf2f(pr[PX_IK + 32 + i]); bf16* o = ki + (size_t)m * 64; o[i] = f2bf(x1 * cs - x2 * sn); o[32 + i] = f2bf(x2 * cs + x1 * sn); } }
        { float v[12]; float ss = 0.f;
#pragma unroll
          for (int j = 0; j < 12; ++j) { v[j] = bf2f(pr[PX_CQ + lane + 64 * j]); ss += v[j] * v[j]; }
          const float rstd = 1.0f / sqrtf(wave_sum(ss) * (1.0f / 768.0f) + EPS);
#pragma unroll
          for (int j = 0; j < 12; ++j) cqn[(size_t)m * 768 + lane + 64 * j] = f2bf(v[j] * rstd * qan[lane + 64 * j]); }
        { float v[8]; float ss = 0.f;
#pragma unroll
          for (int j = 0; j < 8; ++j) { v[j] = bf2f(pr[PX_CKV + lane + 64 * j]); ss += v[j] * v[j]; }
          const float rstd = 1.0f / sqrtf(wave_sum(ss) * (1.0f / 512.0f) + EPS);
#pragma unroll
          for (int j = 0; j < 8; ++j) ckvn[(size_t)m * 512 + lane + 64 * j] = f2bf(v[j] * rstd * kvan[lane + 64 * j]); }
    }
}
__device__ __forceinline__ void transpose_v(Ctx& C, const bf16* src, int pitch, int col0, int hstride, bf16* dst) {
    LAS bf16* tile = (LAS bf16*)C.lds;
    for (int u = C.bid; u < NB * 8 * 32; u += C.G) {
        const int tc = u & 31, h = (u >> 5) & 7, b = u >> 8;
        __syncthreads();
#pragma unroll
        for (int i = 0; i < 2; ++i) { const int idx = C.tid + i * 512, tl = idx >> 4, dc = idx & 15;
            const u32x4 v = *(const u32x4*)(src + (size_t)(b * T + tc * 64 + tl) * pitch + col0 + h * hstride + dc * 8); *(LAS u32x4*)(tile + tl * 136 + dc * 8) = v; }
        __syncthreads();
#pragma unroll
        for (int i = 0; i < 2; ++i) { const int idx = C.tid + i * 512, d = idx >> 3, t8 = idx & 7; const LAS bf16* s = tile + (t8 * 8) * 136 + d;
            u32x4 o; o.x = (unsigned)s[0] | ((unsigned)s[136] << 16); o.y = (unsigned)s[2 * 136] | ((unsigned)s[3 * 136] << 16); o.z = (unsigned)s[4 * 136] | ((unsigned)s[5 * 136] << 16); o.w = (unsigned)s[6 * 136] | ((unsigned)s[7 * 136] << 16);
#ifdef TV_SHORT_STORES
            { bf16* dp = dst + ((size_t)((b * 8 + h) * 128 + d)) * T + tc * 64 + t8 * 8; dp[0] = (bf16)(o.x & 0xffff); dp[1] = (bf16)(o.x >> 16); dp[2] = (bf16)(o.y & 0xffff); dp[3] = (bf16)(o.y >> 16); dp[4] = (bf16)(o.z & 0xffff); dp[5] = (bf16)(o.z >> 16); dp[6] = (bf16)(o.w & 0xffff); dp[7] = (bf16)(o.w >> 16); }
#else
            *(u32x4*)(dst + ((size_t)((b * 8 + h) * 128 + d)) * T + tc * 64 + t8 * 8) = o;
#endif
            }
    }
    __syncthreads();
}

__device__ __forceinline__ void topk_select(const LAS float* scw, int t, u64* maskrow, int lane) {
    u64 myword = 0;
    if (t + 1 <= 256) { int nv = t + 1 - 64 * lane; nv = nv < 0 ? 0 : (nv > 64 ? 64 : nv); myword = nv >= 64 ? ~0ull : ((1ull << nv) - 1ull); }
    else {
        unsigned u[32];
#pragma unroll
        for (int jj = 0; jj < 32; ++jj) { const unsigned bits = __builtin_bit_cast(unsigned, scw[jj * 64 + lane]); const unsigned uu = (bits & 0x80000000u) ? ~bits : (bits | 0x80000000u); u[jj] = (jj * 64 + lane <= t) ? uu : 0u; }
        unsigned tau = 0u;
        const int njj = (t >> 6) + 1;
        for (int bit = 31; bit >= 0; --bit) { const unsigned cand = tau | (1u << bit); int c = 0;
#pragma unroll
            for (int jj = 0; jj < 8; ++jj) c += (u[jj] >= cand) ? 1 : 0;
            if (njj > 8) {
#pragma unroll
                for (int jj = 8; jj < 16; ++jj) c += (u[jj] >= cand) ? 1 : 0; }
            if (njj > 16) {
#pragma unroll
                for (int jj = 16; jj < 24; ++jj) c += (u[jj] >= cand) ? 1 : 0; }
            if (njj > 24) {
#pragma unroll
                for (int jj = 24; jj < 32; ++jj) c += (u[jj] >= cand) ? 1 : 0; }
            const int cnt = wave_sum_i(c);
            if (cnt >= 256) { tau = cand; if (cnt == 256) break; } }
        int cg = 0;
#pragma unroll
        for (int jj = 0; jj < 32; ++jj) cg += (u[jj] > tau) ? 1 : 0;
        int need = 256 - wave_sum_i(cg);
#pragma unroll
        for (int jj = 0; jj < 32; ++jj) { u64 g = __ballot(u[jj] > tau); const u64 e = __ballot(u[jj] == tau);
            if (need > 0 && e != 0ull) { const int c = __popcll(e);
                if (c <= need) { g |= e; need -= c; }
                else { u64 keep = 0ull, ee = e; for (int q = 0; q < need; ++q) { keep |= ee & (0ull - ee); ee &= ee - 1ull; } g |= keep; need = 0; } }
            if (lane == jj) myword = g; }
    }
    if (lane < 32) maskrow[lane] = myword;
}
__device__ __forceinline__ void indexer_naive(Ctx& C, const bf16* proj, const bf16* qi, const bf16* ki, u64* sel) {
    LAS float* qf = (LAS float*)(C.lds + C.wave * 16384); LAS float* scw = qf + 1024;
    const int gw = C.bid * 8 + C.wave, NGW = C.G * 8, lane = C.lane;
    for (int m = gw; m < M; m += NGW) {
        const int b = m >> 11, t = m & (T - 1);
        if (t + 1 > 256) {
            { const u32x4 a = *(const u32x4*)(qi + (size_t)m * 1024 + lane * 16), c = *(const u32x4*)(qi + (size_t)m * 1024 + lane * 16 + 8); LAS float* o = qf + lane * 16;
              o[0] = bflo(a.x); o[1] = bfhi(a.x); o[2] = bflo(a.y); o[3] = bfhi(a.y); o[4] = bflo(a.z); o[5] = bfhi(a.z); o[6] = bflo(a.w); o[7] = bfhi(a.w);
              o[8] = bflo(c.x); o[9] = bfhi(c.x); o[10] = bflo(c.y); o[11] = bfhi(c.y); o[12] = bflo(c.z); o[13] = bfhi(c.z); o[14] = bflo(c.w); o[15] = bfhi(c.w); }
            const float iwv = lane < 16 ? bf2f(proj[(size_t)m * PROJ_N + PX_IW + lane]) : 0.f;
            asm volatile("s_waitcnt lgkmcnt(0)" ::: "memory");
#pragma nounroll
            for (int jj = 0; jj < 32; ++jj) {
                if (jj * 64 > t) { scw[jj * 64 + lane] = -INFINITY; continue; }
                const int key = jj * 64 + lane; const u32x4* kp = (const u32x4*)(ki + (size_t)(b * T + key) * 64); float kf[64];
#pragma unroll
                for (int c8 = 0; c8 < 8; ++c8) { const u32x4 kv = kp[c8]; kf[c8 * 8 + 0] = bflo(kv.x); kf[c8 * 8 + 1] = bfhi(kv.x); kf[c8 * 8 + 2] = bflo(kv.y); kf[c8 * 8 + 3] = bfhi(kv.y); kf[c8 * 8 + 4] = bflo(kv.z); kf[c8 * 8 + 5] = bfhi(kv.z); kf[c8 * 8 + 6] = bflo(kv.w); kf[c8 * 8 + 7] = bfhi(kv.w); }
                float s = 0.f;
#pragma nounroll
                for (int h = 0; h < 16; ++h) { const float wh = rd_lane(iwv, h); float d = 0.f;
#pragma unroll
                    for (int i4 = 0; i4 < 16; ++i4) { const f32x4 q4 = *(const LAS f32x4*)(qf + h * 64 + i4 * 4); d += q4[0] * kf[i4 * 4] + q4[1] * kf[i4 * 4 + 1] + q4[2] * kf[i4 * 4 + 2] + q4[3] * kf[i4 * 4 + 3]; }
                    s += wh * fmaxf(d, 0.f); }
                scw[key] = (key <= t) ? s : -INFINITY;
            }
            asm volatile("s_waitcnt lgkmcnt(0)" ::: "memory");
        }
        topk_select(scw, t, sel + (size_t)m * 32, lane);
    }
}

__device__ __forceinline__ void sparse_attn_naive(Ctx& C, const bf16* proj, const bf16* qs, const bf16* ks, const u64* sel, bf16* outb) {
    LAS float* qf = (LAS float*)(C.lds + C.wave * 16384); LAS float* scw = qf + 256;
    const int gw = C.bid * 8 + C.wave, NGW = C.G * 8, lane = C.lane;
    for (int m = gw; m < M; m += NGW) {
        const int b = m >> 11;
        unsigned wlo = 0u, whi = 0u; if (lane < 32) { const u64 w = sel[(size_t)m * 32 + lane]; wlo = (unsigned)w; whi = (unsigned)(w >> 32); }
        for (int h = 0; h < 8; ++h) {
            qf[lane] = bf2f(qs[(size_t)m * 1024 + h * 128 + lane]); qf[64 + lane] = bf2f(qs[(size_t)m * 1024 + h * 128 + 64 + lane]);
            asm volatile("s_waitcnt lgkmcnt(0)" ::: "memory");
            float mx = -INFINITY;
            for (int jj = 0; jj < 32; ++jj) { const u64 w = ((u64)rd_lane_u(whi, jj) << 32) | (u64)rd_lane_u(wlo, jj); if (w == 0ull) continue;
                float s = -INFINITY;
                if ((w >> lane) & 1ull) { const u32x4* kp = (const u32x4*)(ks + (size_t)(b * T + jj * 64 + lane) * 1024 + h * 128); float d = 0.f;
#pragma unroll
                    for (int c8 = 0; c8 < 16; ++c8) { const u32x4 kv = kp[c8]; const f32x4 q0 = *(const LAS f32x4*)(qf + c8 * 8), q1 = *(const LAS f32x4*)(qf + c8 * 8 + 4);
                        d += q0[0] * bflo(kv.x) + q0[1] * bfhi(kv.x) + q0[2] * bflo(kv.y) + q0[3] * bfhi(kv.y) + q1[0] * bflo(kv.z) + q1[1] * bfhi(kv.z) + q1[2] * bflo(kv.w) + q1[3] * bfhi(kv.w); }
                    s = d; }
                scw[jj * 64 + lane] = s; mx = fmaxf(mx, s); }
            mx = wave_max(mx);
            float sum = 0.f;
            for (int jj = 0; jj < 32; ++jj) { const u64 w = ((u64)rd_lane_u(whi, jj) << 32) | (u64)rd_lane_u(wlo, jj); if (w == 0ull) continue;
                const float s = scw[jj * 64 + lane]; const float p = ((w >> lane) & 1ull) ? __expf(s - mx) : 0.f; scw[jj * 64 + lane] = p; sum += p; }
            sum = wave_sum(sum);
            asm volatile("s_waitcnt lgkmcnt(0)" ::: "memory");
            float a0 = 0.f, a1 = 0.f;
            for (int jj = 0; jj < 32; ++jj) { u64 w = ((u64)rd_lane_u(whi, jj) << 32) | (u64)rd_lane_u(wlo, jj);
                while (w) { const int bit = __builtin_ctzll(w); w &= w - 1ull; const float p = scw[jj * 64 + bit]; const bf16* vp = proj + (size_t)(b * T + jj * 64 + bit) * PROJ_N + PX_AV + h * 128;
                    a0 += p * bf2f(vp[lane]); a1 += p * bf2f(vp[64 + lane]); } }
            const float inv = 1.0f / sum; outb[(size_t)m * 1024 + h * 128 + lane] = f2bf(a0 * inv); outb[(size_t)m * 1024 + h * 128 + 64 + lane] = f2bf(a1 * inv);
        }
    }
}
__device__ __forceinline__ void mla_attn_naive(Ctx& C, const bf16* qm, const bf16* km, const bf16* kvmr, bf16* outc) {
    LAS float* qf = (LAS float*)(C.lds + C.wave * 16384); LAS float* scw = qf + 256;
    const int gw = C.bid * 8 + C.wave, NGW = C.G * 8, lane = C.lane;
    for (int m = gw; m < M; m += NGW) {
        const int b = m >> 11, t = m & (T - 1), njj = (t >> 6) + 1;
        for (int h = 0; h < 8; ++h) {
            qf[lane] = bf2f(qm[(size_t)m * 1536 + h * 192 + lane]); qf[64 + lane] = bf2f(qm[(size_t)m * 1536 + h * 192 + 64 + lane]); qf[128 + lane] = bf2f(qm[(size_t)m * 1536 + h * 192 + 128 + lane]);
            asm volatile("s_waitcnt lgkmcnt(0)" ::: "memory");
            float mx = -INFINITY;
            for (int jj = 0; jj < njj; ++jj) { const int key = jj * 64 + lane; float s = -INFINITY;
                if (key <= t) { const u32x4* kp = (const u32x4*)(km + (size_t)(b * T + key) * 1536 + h * 192); float d = 0.f;
#pragma unroll
                    for (int c8 = 0; c8 < 24; ++c8) { const u32x4 kv = kp[c8]; const f32x4 q0 = *(const LAS f32x4*)(qf + c8 * 8), q1 = *(const LAS f32x4*)(qf + c8 * 8 + 4);
                        d += q0[0] * bflo(kv.x) + q0[1] * bfhi(kv.x) + q0[2] * bflo(kv.y) + q0[3] * bfhi(kv.y) + q1[0] * bflo(kv.z) + q1[1] * bfhi(kv.z) + q1[2] * bflo(kv.w) + q1[3] * bfhi(kv.w); }
                    s = d; }
                scw[key] = s; mx = fmaxf(mx, s); }
            mx = wave_max(mx);
            float sum = 0.f;
            for (int jj = 0; jj < njj; ++jj) { const int key = jj * 64 + lane; const float s = scw[key]; const float p = (key <= t) ? __expf(s - mx) : 0.f; scw[key] = p; sum += p; }
            sum = wave_sum(sum);
            asm volatile("s_waitcnt lgkmcnt(0)" ::: "memory");
            float a0 = 0.f, a1 = 0.f;
            for (int key = 0; key <= t; ++key) { const float p = scw[key]; const bf16* vp = kvmr + (size_t)(b * T + key) * 2048 + h * 256 + 128; a0 += p * bf2f(vp[lane]); a1 += p * bf2f(vp[64 + lane]); }
            const float inv = 1.0f / sum; outc[(size_t)m * 1024 + h * 128 + lane] = f2bf(a0 * inv); outc[(size_t)m * 1024 + h * 128 + 64 + lane] = f2bf(a1 * inv);
        }
    }
}

template <int DQK, bool SPARSE>
__device__ __forceinline__ void attn_mfma(Ctx& C, const bf16* __restrict__ Q, const bf16* __restrict__ K, const bf16* __restrict__ Vt, const u64* __restrict__ sel, bf16* __restrict__ O) {
    constexpr int NC = DQK / 32, NCB = DQK / 64, KTB = NCB * 8192, VTB = 2 * 8192, NP = NCB + 2 + (SPARSE ? 1 : 0);
    constexpr int MOFF = 3 * KTB + 3 * VTB, MSB = 8 * 256;
    static_assert(MOFF + 3 * MSB <= LDS_RING, "attention LDS");
    constexpr float LOG2E = 1.4426950408889634f;
    const int lane = C.lane, wave = C.wave, r = lane & 15, g = lane >> 4;
    LAS unsigned char* const lds = C.lds;
    const unsigned ldsw = (unsigned)(size_t)lds + (unsigned)(wave * 1024);
    const unsigned ldsm = (unsigned)(size_t)lds + (unsigned)(MOFF + wave * 256);
    const int sb = lane * 16, swz = sb ^ (((sb >> 9) & 1) << 5), srow = 16 * (wave >> 1) + (swz >> 6), scol = 32 * (wave & 1) + ((swz & 63) >> 1);
    const unsigned koff = (unsigned)(srow * 8 * DQK * 2 + scol * 2);
    const unsigned voff = (unsigned)(srow * T * 2 + scol * 2);
    const int rk = (r * 64 + g * 16) ^ ((r >> 3) << 5);
    const int rv0 = (r * 64 + g * 8) ^ ((r >> 3) << 5), rv1 = rv0 ^ 32;
#define ATT_WAIT(n_) asm volatile("s_waitcnt vmcnt(" #n_ ")" ::: "memory")
    for (int unit = C.bid; unit < 256; unit += C.G) {
        const int pbh = (unit & 7) + 8 * (unit >> 6), b = pbh >> 3, h = pbh & 7, x = (unit >> 3) & 7;
        const int qblk = (wave >> 2) ? (15 - x) : x, q0 = qblk * 128 + (wave & 3) * 32;
        const int nkt = 2 * (16 - x), my_last = (q0 + 31) >> 6;
        bf16x8 qf[2][NC];
#pragma unroll
        for (int mt = 0; mt < 2; ++mt)
#pragma unroll
            for (int c = 0; c < NC; ++c) qf[mt][c] = *(const bf16x8*)(Q + ((size_t)(b * T + q0 + 16 * mt + r) * 8 + h) * DQK + 32 * c + 8 * g);
        f32x4 Oa[2][8];
#pragma unroll
        for (int mt = 0; mt < 2; ++mt)
#pragma unroll
            for (int n = 0; n < 8; ++n) Oa[mt][n] = (f32x4){0.f, 0.f, 0.f, 0.f};
        float mrun[2] = {-INFINITY, -INFINITY}, lrun[2] = {0.f, 0.f};
        const char* Kb = (const char*)(K + ((size_t)(b * T) * 8 + h) * DQK); const char* Vb = (const char*)(Vt + (size_t)((b * 8 + h) * 128) * T);
        const char* selb = SPARSE ? (const char*)(sel + (size_t)(b * T + q0 + (lane >> 1)) * 32) + (lane & 1) * 4 : nullptr;
#define ATT_DMA(gp_, la_) asm volatile("s_mov_b32 m0, %0\n\ts_nop 0\n\tglobal_load_lds_dwordx4 %1, off" :: "s"(la_), "v"(gp_) : "memory", "m0")
#define ATT_LOAD(kt_, buf_) do { const unsigned lb_ = __builtin_amdgcn_readfirstlane(ldsw + (unsigned)((buf_) * KTB)), lv_ = __builtin_amdgcn_readfirstlane(ldsw + (unsigned)(3 * KTB + (buf_) * VTB)); \
        _Pragma("unroll") for (int cb_ = 0; cb_ < NCB; ++cb_) ATT_DMA(Kb + (size_t)(kt_) * (64 * 8 * DQK * 2) + koff + cb_ * 128, lb_ + cb_ * 8192); \
        _Pragma("unroll") for (int rb_ = 0; rb_ < 2; ++rb_) ATT_DMA(Vb + (size_t)(kt_) * 128 + voff + rb_ * (64 * T * 2), lv_ + rb_ * 8192); \
        if (SPARSE) { const unsigned lm_ = __builtin_amdgcn_readfirstlane(ldsm + (unsigned)((buf_) * MSB)); \
            asm volatile("s_mov_b32 m0, %0\n\ts_nop 0\n\tglobal_load_lds_dword %1, off" :: "s"(lm_), "v"(selb + (size_t)(kt_) * 8) : "memory", "m0"); } } while (0)
        __builtin_amdgcn_s_waitcnt(0x0070); asm volatile("" ::: "memory"); __builtin_amdgcn_s_barrier();
        ATT_LOAD(0, 0);
        if (nkt > 1) ATT_LOAD(1, 1);
        ATT_WAIT(0);
        __builtin_amdgcn_s_barrier();
        int cb = 0;
        for (int kt = 0; kt < nkt; ++kt) {
            const bool more2 = kt + 2 < nkt; const int nb2 = (cb == 0) ? 2 : cb - 1;
            if (more2) ATT_LOAD(kt + 2, nb2);
            if (kt <= my_last) {
                const LAS unsigned char* kb = lds + cb * KTB + rk; const LAS unsigned char* vb = lds + 3 * KTB + cb * VTB;
                f32x4 S[2][4];
#pragma unroll
                for (int mt = 0; mt < 2; ++mt)
#pragma unroll
                    for (int s4 = 0; s4 < 4; ++s4) S[mt][s4] = (f32x4){0.f, 0.f, 0.f, 0.f};
#define KFRAG(i_) (*(const LAS bf16x8*)(kb + (((i_) >> 2) >> 1) * 8192 + (((i_) & 3) * 2 + (((i_) >> 2) & 1)) * 1024))
#define VFRAG(j_, dst_) do { const LAS unsigned char* vp_ = vb + (((j_) & 7) >> 2) * 8192 + ((((j_) & 7) & 3) * 2 + ((j_) >> 3)) * 1024; const u32x2 v0_ = *(const LAS u32x2*)(vp_ + rv0), v1_ = *(const LAS u32x2*)(vp_ + rv1); \
                    u32x4 w_; w_.x = v0_.x; w_.y = v0_.y; w_.z = v1_.x; w_.w = v1_.y; dst_ = __builtin_bit_cast(bf16x8, w_); } while (0)
                constexpr int PD = 4, RG = PD + 1, NS = 4 * NC;
                bf16x8 kr[RG];
#pragma unroll
                for (int i = 0; i < PD; ++i) kr[i] = KFRAG(i);
                __builtin_amdgcn_sched_barrier(0);
#pragma unroll
                for (int i = 0; i < NS; ++i) { const int c = i >> 2, s4 = i & 3;
                    if (i + PD < NS) kr[(i + PD) % RG] = KFRAG(i + PD);
                    S[0][s4] = __builtin_amdgcn_mfma_f32_16x16x32_bf16(kr[i % RG], qf[0][c], S[0][s4], 0, 0, 0); S[1][s4] = __builtin_amdgcn_mfma_f32_16x16x32_bf16(kr[i % RG], qf[1][c], S[1][s4], 0, 0, 0);
                    __builtin_amdgcn_sched_barrier(0); }
                bf16x8 vr[RG];
#pragma unroll
                for (int j = 0; j < PD; ++j) VFRAG(j, vr[j]);
                __builtin_amdgcn_sched_barrier(0);
                bf16x8 pf[2][2];
                const bool diag = (64 * kt + 63 > q0);
                u32x2 wsel[2] = {(u32x2){0u, 0u}, (u32x2){0u, 0u}};
                if (SPARSE) { const LAS unsigned char* mb = lds + MOFF + cb * MSB + wave * 256 + r * 8; wsel[0] = *(const LAS u32x2*)mb; wsel[1] = *(const LAS u32x2*)(mb + 128); }
#pragma unroll
                for (int mt = 0; mt < 2; ++mt) {
                    const int qrow = q0 + 16 * mt + r; float mx = -INFINITY;
                    if (SPARSE || diag) {
#pragma unroll
                        for (int s4 = 0; s4 < 4; ++s4) {
                            unsigned nib = 0u; if (SPARSE) { const unsigned hw_ = (s4 < 2) ? wsel[mt].x : wsel[mt].y; nib = (hw_ >> (16 * (s4 & 1) + 4 * g)) & 15u; }
#pragma unroll
                            for (int i = 0; i < 4; ++i) { bool ok;
                                if (SPARSE) ok = (nib >> i) & 1u; else ok = (64 * kt + 16 * s4 + 4 * g + i <= qrow);
                                S[mt][s4][i] = ok ? S[mt][s4][i] : -INFINITY; } } }
#pragma unroll
                    for (int s4 = 0; s4 < 4; ++s4)
#pragma unroll
                        for (int i = 0; i < 4; ++i) mx = fmaxf(mx, S[mt][s4][i]);
                    mx = fmaxf(mx, __shfl_xor(mx, 16)); mx = fmaxf(mx, __shfl_xor(mx, 32));
                    const float mnew = fmaxf(mrun[mt], mx), msafe = (mnew == -INFINITY) ? 0.f : mnew, ml = msafe * LOG2E;
                    const float alpha = __builtin_amdgcn_exp2f((mrun[mt] - msafe) * LOG2E); mrun[mt] = mnew;
                    float ps = 0.f;
#pragma unroll
                    for (int s4 = 0; s4 < 4; ++s4)
#pragma unroll
                        for (int i = 0; i < 4; ++i) { const float p = __builtin_amdgcn_exp2f(S[mt][s4][i] * LOG2E - ml); S[mt][s4][i] = p; ps += p; }
                    lrun[mt] = lrun[mt] * alpha + ps;
                    if (__builtin_amdgcn_ballot_w64(alpha != 1.0f)) {
#pragma unroll
                        for (int n = 0; n < 8; ++n) Oa[mt][n] = Oa[mt][n] * alpha; }
#pragma unroll
                    for (int c = 0; c < 2; ++c) { u32x4 w; w.x = pk2(S[mt][2 * c][0], S[mt][2 * c][1]); w.y = pk2(S[mt][2 * c][2], S[mt][2 * c][3]); w.z = pk2(S[mt][2 * c + 1][0], S[mt][2 * c + 1][1]); w.w = pk2(S[mt][2 * c + 1][2], S[mt][2 * c + 1][3]);
                        pf[mt][c] = __builtin_bit_cast(bf16x8, w); }
                }
                __builtin_amdgcn_sched_barrier(0);
#pragma unroll
                for (int j = 0; j < 16; ++j) { const int c = j >> 3, n = j & 7;
                    if (j + PD < 16) VFRAG(j + PD, vr[(j + PD) % RG]);
                    Oa[0][n] = __builtin_amdgcn_mfma_f32_16x16x32_bf16(vr[j % RG], pf[0][c], Oa[0][n], 0, 0, 0); Oa[1][n] = __builtin_amdgcn_mfma_f32_16x16x32_bf16(vr[j % RG], pf[1][c], Oa[1][n], 0, 0, 0);
                    __builtin_amdgcn_sched_barrier(0); }
#undef KFRAG
#undef VFRAG
            }
            if (more2) asm volatile("s_waitcnt vmcnt(%0)" :: "n"(NP) : "memory"); else ATT_WAIT(0);
            asm volatile("s_waitcnt lgkmcnt(0)" ::: "memory"); __builtin_amdgcn_s_barrier();
            cb = (cb == 2) ? 0 : cb + 1;
        }
#pragma unroll
        for (int mt = 0; mt < 2; ++mt) { float l = lrun[mt]; l += __shfl_xor(l, 16); l += __shfl_xor(l, 32); const float inv = 1.0f / l;
            bf16* op = O + (size_t)(b * T + q0 + 16 * mt + r) * 1024 + h * 128 + 4 * g;
#pragma unroll
            for (int n = 0; n < 8; ++n) { const f32x4 o = Oa[mt][n] * inv; u32x2 w; w.x = pk2(o[0], o[1]); w.y = pk2(o[2], o[3]); *(u32x2*)(op + 16 * n) = w; } }
#undef ATT_LOAD
#undef ATT_DMA
    }
#undef ATT_WAIT
    __syncthreads();
}

__device__ __forceinline__ void indexer_mfma(Ctx& C, const bf16* proj, const bf16* qi, const bf16* ki, u64* sel) {
    LAS float* scw = (LAS float*)(C.lds + C.wave * 16384);
    const int gw = C.bid * 8 + C.wave, NGW = C.G * 8, lane = C.lane, r = lane & 15, g = lane >> 4;
    for (int P = gw, it = 0; P < M / 2; P += NGW, ++it) {
        const int b = P >> 10, pp = P & 1023, t0 = (it & 1) ? (2046 - 2 * pp) : (2 * pp), m0 = b * T + t0;
        if (t0 + 2 > 256) {
            bf16x8 a0[2], a1[2]; float w0[2], w1[2], w2[2], w3[2];
#pragma unroll
            for (int q = 0; q < 2; ++q) { a0[q] = *(const bf16x8*)(qi + (size_t)(m0 + q) * 1024 + r * 64 + 8 * g); a1[q] = *(const bf16x8*)(qi + (size_t)(m0 + q) * 1024 + r * 64 + 32 + 8 * g);
                const u32x2 ww = *(const u32x2*)(proj + (size_t)(m0 + q) * PROJ_N + PX_IW + 4 * g); w0[q] = bflo(ww.x); w1[q] = bfhi(ww.x); w2[q] = bflo(ww.y); w3[q] = bfhi(ww.y); }
            const int njj = ((t0 + 1) >> 6) + 1;
            const bf16* kp = ki + (size_t)(b * T + r) * 64 + 8 * g; bf16x8 kb[4][2], kn[4][2];
#pragma unroll
            for (int s4 = 0; s4 < 4; ++s4) { kb[s4][0] = *(const bf16x8*)(kp + s4 * 16 * 64); kb[s4][1] = *(const bf16x8*)(kp + s4 * 16 * 64 + 32); }
#pragma nounroll
            for (int jj = 0; jj < njj; ++jj) {
                const bf16* kq = kp + (size_t)((jj + 1 < njj) ? (jj + 1) : jj) * 64 * 64;
#pragma unroll
                for (int s4 = 0; s4 < 4; ++s4) { kn[s4][0] = *(const bf16x8*)(kq + s4 * 16 * 64); kn[s4][1] = *(const bf16x8*)(kq + s4 * 16 * 64 + 32); }
                float val[2] = {0.f, 0.f};
#pragma unroll
                for (int s4 = 0; s4 < 4; ++s4)
#pragma unroll
                    for (int q = 0; q < 2; ++q) { f32x4 d = (f32x4){0.f, 0.f, 0.f, 0.f};
                        d = __builtin_amdgcn_mfma_f32_16x16x32_bf16(a0[q], kb[s4][0], d, 0, 0, 0); d = __builtin_amdgcn_mfma_f32_16x16x32_bf16(a1[q], kb[s4][1], d, 0, 0, 0);
                        float part = w0[q] * relu_(d[0]) + w1[q] * relu_(d[1]) + w2[q] * relu_(d[2]) + w3[q] * relu_(d[3]);
                        part += __shfl_xor(part, 16); part += __shfl_xor(part, 32);
                        val[q] = (g == s4) ? part : val[q]; }
                scw[jj * 64 + lane] = val[0]; scw[2048 + jj * 64 + lane] = val[1];
#pragma unroll
                for (int s4 = 0; s4 < 4; ++s4) { kb[s4][0] = kn[s4][0]; kb[s4][1] = kn[s4][1]; }
            }
            asm volatile("s_waitcnt lgkmcnt(0)" ::: "memory");
        }
        topk_select(scw, t0, sel + (size_t)m0 * 32, lane);
        topk_select(scw + 2048, t0 + 1, sel + (size_t)(m0 + 1) * 32, lane);
    }
}

__device__ __forceinline__ void lru_scan(Ctx& C, const bf16* la, const bf16* lb, const bf16* proj, bf16* outa) {
    LAS float* cA = (LAS float*)C.lds; LAS float* cB = cA + 512;
    for (int u = C.bid; u < 256; u += C.G) {
        const int b = u >> 6, cg = u & 63, cl = C.tid & 15, chunk = C.tid >> 4, ch = cg * 16 + cl;
        const size_t base = (size_t)(b * T + chunk * 64) * 1024 + ch;
        float A = 1.f, Bv = 0.f;
        unsigned pk[64];
#pragma unroll
        for (int s = 0; s < 64; ++s) pk[s] = (unsigned)__builtin_bit_cast(unsigned short, la[base + (size_t)s * 1024]) | ((unsigned)__builtin_bit_cast(unsigned short, lb[base + (size_t)s * 1024]) << 16);
#pragma unroll
        for (int s = 0; s < 64; ++s) { const float a = 1.0f - bflo(pk[s]), bb = bfhi(pk[s]); Bv = a * Bv + bb; A *= a; }
        __syncthreads();
        cA[chunk * 16 + cl] = A; cB[chunk * 16 + cl] = Bv;
        __syncthreads();
        float H = 0.f;
        for (int j = 0; j < chunk; ++j) H = cA[j * 16 + cl] * H + cB[j * 16 + cl];
#pragma unroll
        for (int s = 0; s < 64; ++s) { const float a = 1.0f - bflo(pk[s]), bb = bfhi(pk[s]); H = a * H + bb;
            const size_t m = (size_t)(b * T + chunk * 64 + s); const float g = bf2f(proj[m * PROJ_N + PX_LRUG + ch]); outa[m * 1024 + ch] = f2bf(H * gelu_tanh(g)); }
    }
    __syncthreads();
}

__device__ __forceinline__ void mla_post(Ctx& C, const bf16* proj, const int* pos, const bf16* qmr, const bf16* kvmr, const float* qn, const float* kn, bf16* qm, bf16* km) {
    const int gw = C.bid * 8 + C.wave, NGW = C.G * 8, lane = C.lane, i = lane & 31;
    const float QMSCALE = 0.07216878364870323f;
    for (int m = gw; m < M; m += NGW) {
        float sn, cs; rope_sc((float)pos[m], i, 64, sn, cs);
        const float kr1 = bf2f(proj[(size_t)m * PROJ_N + PX_KR + i]), kr2 = bf2f(proj[(size_t)m * PROJ_N + PX_KR + 32 + i]);
#pragma unroll
        for (int h = 0; h < 8; ++h) {
            { const bf16* q = qmr + (size_t)m * 1536 + h * 192; const float x0 = bf2f(q[lane]), x1 = bf2f(q[64 + lane]), r1 = bf2f(q[128 + i]), r2 = bf2f(q[160 + i]);
              const float ss = wave_sum(x0 * x0 + x1 * x1 + (lane < 32 ? r1 * r1 + r2 * r2 : 0.f)); const float rstd = 1.0f / sqrtf(ss * (1.0f / 192.0f) + EPS) * QMSCALE;
              bf16* o = qm + (size_t)m * 1536 + h * 192; o[lane] = f2bf(x0 * rstd * qn[lane]); o[64 + lane] = f2bf(x1 * rstd * qn[64 + lane]);
              const float z1 = r1 * rstd * qn[128 + i], z2 = r2 * rstd * qn[160 + i]; if (lane < 32) { o[128 + i] = f2bf(z1 * cs - z2 * sn); o[160 + i] = f2bf(z2 * cs + z1 * sn); } }
            { const bf16* k = kvmr + (size_t)m * 2048 + h * 256; const float x0 = bf2f(k[lane]), x1 = bf2f(k[64 + lane]);
              const float ss = wave_sum(x0 * x0 + x1 * x1 + (lane < 32 ? kr1 * kr1 + kr2 * kr2 : 0.f)); const float rstd = 1.0f / sqrtf(ss * (1.0f / 192.0f) + EPS);
              bf16* o = km + (size_t)m * 1536 + h * 192; o[lane] = f2bf(x0 * rstd * kn[lane]); o[64 + lane] = f2bf(x1 * rstd * kn[64 + lane]);
              const float z1 = kr1 * rstd * kn[128 + i], z2 = kr2 * rstd * kn[160 + i]; if (lane < 32) { o[128 + i] = f2bf(z1 * cs - z2 * sn); o[160 + i] = f2bf(z2 * cs + z1 * sn); } }
        }
    }
}

__device__ __forceinline__ void moe_route(Ctx& C, int* mi) {
    if (C.bid != 0) return;
    LAS int* hist = (LAS int*)C.lds;
    LAS int* tot = hist + 8 * 512;
    const int* toke = mi + MI_TOKE; const float* tokg = (const float*)(mi + MI_TOKG); int* dest = mi + MI_DEST; int* rowtok = mi + MI_ROWTOK; float* rowg = (float*)(mi + MI_ROWG); int* blke = mi + MI_BLKE;
    const int tid = C.tid, lane = C.lane;
    for (int i = tid; i < MOE_ROWS; i += 512) { rowtok[i] = M; rowg[i] = 0.f; }
    int cnt[8];
#pragma unroll
    for (int e = 0; e < 8; ++e) cnt[e] = 0;
    for (int j = 0; j < 32; ++j) { const int ee = toke[tid * 32 + j];
#pragma unroll
        for (int e = 0; e < 8; ++e) cnt[e] += (ee == e) ? 1 : 0; }
#pragma unroll
    for (int e = 0; e < 8; ++e) hist[e * 512 + tid] = cnt[e];
    __syncthreads();
    { const int e = C.wave; int v[8]; int s = 0;
#pragma unroll
      for (int j = 0; j < 8; ++j) { v[j] = hist[e * 512 + lane * 8 + j]; s += v[j]; }
      int incl = s;
#pragma unroll
      for (int o = 1; o < 64; o <<= 1) { const int y = __shfl_up(incl, o); if (lane >= o) incl += y; }
      int run = incl - s;
#pragma unroll
      for (int j = 0; j < 8; ++j) { hist[e * 512 + lane * 8 + j] = run; run += v[j]; }
      if (lane == 63) tot[e] = incl; }
    __syncthreads();
    int base[8]; int ps = 0; int pend[8];
#pragma unroll
    for (int e = 0; e < 8; ++e) { const int pad = (tot[e] + 255) / 256 * 256; base[e] = ps + hist[e * 512 + tid]; ps += pad; pend[e] = ps; }
    for (int j = 0; j < 32; ++j) { const int a = tid * 32 + j; const int ee = toke[a]; int d = 0;
#pragma unroll
        for (int e = 0; e < 8; ++e) if (ee == e) { d = base[e]; base[e] += 1; }
        dest[a] = d; rowtok[d] = a >> 1; rowg[d] = tokg[a]; }
    if (tid < MOE_BLKS) { int e = 0;
#pragma unroll
        for (int q = 0; q < 8; ++q) e += (pend[q] <= tid * 256) ? 1 : 0;
        blke[tid] = e > 7 ? 7 : e; }
    if (tid == 0) { mi[MI_NUSED] = ps / 256; mi[MI_BSTART] = 0; }
    if (tid < 8) { int pe = 0;
#pragma unroll
        for (int q = 0; q < 8; ++q) pe = (tid == q) ? pend[q] : pe;
        mi[MI_BSTART + 1 + tid] = pe / 256; }
    __syncthreads();
}
__device__ __forceinline__ void moe_gather_fp8(Ctx& C, const int* mi, const bf16* hn, unsigned char* xs) {
    const int gw = C.bid * 8 + C.wave, NGW = C.G * 8, lane = C.lane; const int nrows = mi[MI_NUSED] * 256; const int* rowtok = mi + MI_ROWTOK;
    for (int r = gw; r < nrows; r += NGW) { const int tok = rowtok[r]; u32x4* o = (u32x4*)(xs + (size_t)r * D + lane * 32);
        if (tok < M) { const u32x4* sp = (const u32x4*)(hn + (size_t)tok * D + lane * 32); u32x4 ov[2];
#pragma unroll
            for (int h2 = 0; h2 < 2; ++h2) { const u32x4 a = sp[2 * h2], b = sp[2 * h2 + 1];
                ov[h2].x = pk4_fp8(bflo(a.x) * F8_XSCALE, bfhi(a.x) * F8_XSCALE, bflo(a.y) * F8_XSCALE, bfhi(a.y) * F8_XSCALE); ov[h2].y = pk4_fp8(bflo(a.z) * F8_XSCALE, bfhi(a.z) * F8_XSCALE, bflo(a.w) * F8_XSCALE, bfhi(a.w) * F8_XSCALE);
                ov[h2].z = pk4_fp8(bflo(b.x) * F8_XSCALE, bfhi(b.x) * F8_XSCALE, bflo(b.y) * F8_XSCALE, bfhi(b.y) * F8_XSCALE); ov[h2].w = pk4_fp8(bflo(b.z) * F8_XSCALE, bfhi(b.z) * F8_XSCALE, bflo(b.w) * F8_XSCALE, bfhi(b.w) * F8_XSCALE); }
            o[0] = ov[0]; o[1] = ov[1]; }
        else { o[0] = (u32x4){0u, 0u, 0u, 0u}; o[1] = (u32x4){0u, 0u, 0u, 0u}; } }
}
__device__ __forceinline__ void moe_gather(Ctx& C, const int* mi, const bf16* hn, bf16* xs) {
    const int gw = C.bid * 8 + C.wave, NGW = C.G * 8, lane = C.lane; const int nrows = mi[MI_NUSED] * 256; const int* rowtok = mi + MI_ROWTOK;
    for (int r = gw; r < nrows; r += NGW) { const int tok = rowtok[r]; u32x4* o = (u32x4*)(xs + (size_t)r * D) + lane;
        if (tok < M) { const u32x4* s = (const u32x4*)(hn + (size_t)tok * D) + lane;
#pragma unroll
            for (int j = 0; j < 4; ++j) o[64 * j] = s[64 * j]; }
        else {
#pragma unroll
            for (int j = 0; j < 4; ++j) o[64 * j] = (u32x4){0u, 0u, 0u, 0u}; } }
}
__device__ __forceinline__ void moe_combine(Ctx& C, const int* mi, const bf16* ys, bf16* h) {
    const int gw = C.bid * 8 + C.wave, NGW = C.G * 8, lane = C.lane; const int* dest = mi + MI_DEST;
    for (int m = gw; m < M; m += NGW) { const int d0 = dest[2 * m], d1 = dest[2 * m + 1];
        u32x2* hp = (u32x2*)(h + (size_t)m * D) + lane; const u32x2* y0 = (const u32x2*)(ys + (size_t)d0 * D) + lane; const u32x2* y1 = (const u32x2*)(ys + (size_t)d1 * D) + lane;
        const size_t slab = (size_t)MOE_ROWS * D / 4;
#pragma unroll
        for (int j = 0; j < 8; ++j) { const u32x2 hw = hp[64 * j], a0 = y0[64 * j], a1 = y0[slab + 64 * j], b0 = y1[64 * j], b1 = y1[slab + 64 * j];
            u32x2 w; w.x = pk2(bflo(hw.x) + ((bflo(a0.x) + bflo(a1.x)) + (bflo(b0.x) + bflo(b1.x))), bfhi(hw.x) + ((bfhi(a0.x) + bfhi(a1.x)) + (bfhi(b0.x) + bfhi(b1.x))));
            w.y = pk2(bflo(hw.y) + ((bflo(a0.y) + bflo(a1.y)) + (bflo(b0.y) + bflo(b1.y))), bfhi(hw.y) + ((bfhi(a0.y) + bfhi(a1.y)) + (bfhi(b0.y) + bfhi(b1.y)))); hp[64 * j] = w; } }
}

constexpr int CW_BGQ = 8192;
constexpr int BG_I1 = 56 * 16, BG_I2 = 8 * 56, BG_N1 = 8 * BG_I1, BG_NITEMS = BG_N1 + 8 * BG_I2;
__device__ __forceinline__ void bg_conv_item(LAS unsigned char* tile, int tid, int w, int L, KArgPtr ka, int item) {
    const float* src; ptrdiff_t du = 0; int srcN, K, n0, k0; unsigned char* dst;
    if (item < BG_N1) { const int e = item / BG_I1, rr = item - e * BG_I1, nb = rr >> 4, kb = rr & 15; n0 = nb * 256; k0 = kb * 128; srcN = EFF; K = 2048;
        src = (const float*)ka->in[27] + (size_t)e * 2048 * EFF; du = (const float*)ka->in[28] - (const float*)ka->in[27]; dst = ka->ws + O_WM1 + (size_t)e * (SZ_WM1 / 2); }
    else { const int j = item - BG_N1, e = j / BG_I2, rr = j - e * BG_I2, nb = rr / 56, kb = rr - nb * 56; n0 = nb * 256; k0 = kb * 128; srcN = 2048; K = EFF;
        src = (const float*)ka->in[29] + (size_t)e * EFF * 2048; dst = ka->ws + O_WM2 + (size_t)e * (SZ_WM2 / 2); }
    const float* sp;
    if (item < BG_N1) { const int n = n0 + 4 * L, tl = n >> 8, r = n & 255; sp = src + (r < 128 ? (ptrdiff_t)0 : du) + tl * 128 + (r & 127); } else sp = src + n0 + 4 * L;
    f32x4 v[16];
#pragma unroll
    for (int j = 0; j < 16; ++j) v[j] = __builtin_nontemporal_load((const f32x4*)(sp + (size_t)(k0 + 16 * w + j) * srcN));
#pragma unroll
    for (int q = 0; q < 4; ++q) { u32x4 o; o.x = pk4_fp8(v[0][q] * F8_WSCALE, v[1][q] * F8_WSCALE, v[2][q] * F8_WSCALE, v[3][q] * F8_WSCALE); o.y = pk4_fp8(v[4][q] * F8_WSCALE, v[5][q] * F8_WSCALE, v[6][q] * F8_WSCALE, v[7][q] * F8_WSCALE);
        o.z = pk4_fp8(v[8][q] * F8_WSCALE, v[9][q] * F8_WSCALE, v[10][q] * F8_WSCALE, v[11][q] * F8_WSCALE); o.w = pk4_fp8(v[12][q] * F8_WSCALE, v[13][q] * F8_WSCALE, v[14][q] * F8_WSCALE, v[15][q] * F8_WSCALE);
        *(LAS u32x4*)(tile + (4 * L + q) * 144 + w * 16) = o; }
    __syncthreads();
#pragma unroll
    for (int i = 0; i < 4; ++i) { const int idx = tid + 512 * i, n = idx >> 3, ch = idx & 7; const u32x4 o = *(const LAS u32x4*)(tile + n * 144 + ch * 16); *(u32x4*)(dst + (size_t)(n0 + n) * K + k0 + ch * 16) = o; }
    __syncthreads();
}
__device__ __forceinline__ void bg_drain(LAS unsigned char* lds, volatile LAS unsigned* misc, int wave, KArgPtr ka) {
    int ln; asm volatile("v_mbcnt_lo_u32_b32 %0, -1, 0\n\tv_mbcnt_hi_u32_b32 %0, -1, %0" : "=v"(ln));
    const int tid = wave * 64 + ln; unsigned* q = (unsigned*)(ka->ws) + CW_BGQ;
    for (;;) {
        if (tid == 0) misc[4] = xb_add(q, 1u);
        __syncthreads();
        const int item = (int)misc[4];
        __syncthreads();
        if (item >= BG_NITEMS) break;
        bg_conv_item(lds, tid, wave, ln, ka, item);
    }
}
__device__ __forceinline__ void xcd_barrier_bg(const XcdBarrier& b, LAS unsigned char* lds, KArgPtr ka) {
    asm volatile("s_waitcnt vmcnt(0)" ::: "memory");
    __syncthreads();
    volatile LAS unsigned* st = b.st;
    const bool t0 = xb_thread0(b.wave);
    if (t0) {
        unsigned* bar = b.bar; unsigned bx = b.x;
        asm volatile("" : "+s"(bar), "+s"(bx));
        __builtin_amdgcn_s_waitcnt(0);
        unsigned nloc = st[0], nx = st[1];
        if (nloc == 0u) { xcd_barrier_complete(bar, bx, nloc, nx); st[0] = nloc; st[1] = nx; }
        const unsigned old = xb_add(&bar[XB_XSUB(bx)], 1u);
        const unsigned gen = old / nloc;
        if (old + 1u == (gen + 1u) * nloc) {
            __builtin_amdgcn_fence(__ATOMIC_RELEASE, "agent");
            asm volatile("s_waitcnt vmcnt(0)" ::: "memory");
            const unsigned og = xb_add(&bar[XB_TOP], 1u);
            const unsigned tg = og / nx;
            if (og + 1u == (tg + 1u) * nx) xb_add(&bar[XB_TOPGEN], 1u);
            else XB_SPIN(xb_ld(&bar[XB_TOPGEN]) == tg, bar);
            __builtin_amdgcn_fence(__ATOMIC_ACQUIRE, "agent");
            xb_add(&bar[XB_XGEN(bx)], 1u);
            asm volatile("s_waitcnt vmcnt(0)" ::: "memory");
            st[2] = 0u;
        } else { st[2] = 2u; st[3] = gen; }
    }
    __syncthreads();
    if (st[2] != 0u) {
        int ln; asm volatile("v_mbcnt_lo_u32_b32 %0, -1, 0\n\tv_mbcnt_hi_u32_b32 %0, -1, %0" : "=v"(ln));
        const int tid = b.wave * 64 + ln; const unsigned gen = st[3];
        unsigned* bar = b.bar; unsigned bx = b.x; asm volatile("" : "+s"(bar), "+s"(bx));
        unsigned* q = bar - CW_BAR + CW_BGQ;
        bool qempty = (BG_NOWAITWORK != 0); unsigned spins = 0u;
        for (;;) {
            if (t0) { unsigned code = 0u;
                if (xb_ld(&bar[XB_XGEN(bx)]) == gen) { code = 1u;
                    if (!qempty) { const unsigned it = xb_add(q, 1u); if (it < (unsigned)BG_NITEMS) code = 2u + it; else qempty = true; }
                    if (code == 1u) { __builtin_amdgcn_s_sleep(2); if ((++spins & 255u) == 0u) { if (xb_ld(&bar[XB_TMO])) code = 0u; else if (spins > (XB_SPIN_CAP << 2)) { atomicAdd(&bar[XB_TMO], 1u); code = 0u; } } } }
                st[4] = code; }
            __syncthreads();
            const unsigned code = st[4];
            __syncthreads();
            if (code == 0u) break;
            if (code >= 2u) bg_conv_item(lds, tid, b.wave, ln, ka, (int)(code - 2u));
        }
        if (t0) { __builtin_amdgcn_fence(__ATOMIC_ACQUIRE, "agent"); asm volatile("s_waitcnt vmcnt(0)" ::: "memory"); }
    }
    __syncthreads();
}

enum { LP_INPROJ = 0, LP_POST, LP_MID1, LP_MID2, LP_MLAATT, LP_BRANCH, LP_WOUT, LP_NORM2, LP_ROUTE, LP_GATHER, LP_FFN1, LP_FFN2, LP_NORM3, LP_PLE, LP_NORM1, NLP };
constexpr int NPH = 1 + 2 * NLP;
__host__ __device__ inline bool phase_active(int ph) {
    if (ph == 0) return true;
    const int l = (ph - 1) / NLP, k = (ph - 1) % NLP;
    if ((k == LP_ROUTE || k == LP_GATHER) && l == 0) return false;
    if (k == LP_NORM1 && l == 1) return false;
    return true;
}

#ifdef ONLY_LP
#define IN(k) (((k) == 0 ? ((ONLY_LP) & 1) : (((ONLY_LP) >> (1 + (((k) - 1) % NLP))) & 1)) && lo <= (k) && (k) < hi)
#else
#define IN(k) (lo <= (k) && (k) < hi)
#endif
#if BG_CONV && FP8_MOE
#define SEAM(k) do { if (multi && (k) + 1 < hi) xcd_barrier_bg(bar, lds0, kargs()); } while (0)
#else
#define SEAM(k) do { if (multi && (k) + 1 < hi) xcd_barrier(bar); } while (0)
#endif
#define INF(i) ((const float*)ka->in[i])

template <int l>
__device__ __forceinline__ void layer_body(const int lo, const int hi, const bool multi, const XcdBarrier& bar, LAS unsigned char* const lds0, const int wave_s) {
        const int p0 = 1 + l * NLP;
        if (IN(p0 + LP_INPROJ)) {
            PHASE_LOCALS;
#if FP8_GATES
            { PlainSched S{WSP(bf16, O_HN), WSP(bf16, O_WIN + l * SZ_WIN), 2048, 2048, 2048, 32, PX_GATE / 256, C.G, C.bid};
              for (int rp = 0; rp < PB(1); ++rp) gemm_run(C, S, EpiBf16{WSP(bf16, O_PROJ), PROJ_N, 0, 1.0f}); }
            { PHASE_LOCALS; PlainSched S{WSP(bf16, O_HN8), WSP(bf16, O_WIN + l * SZ_WIN + (size_t)PX_GATE * 2048 * 2), 1024, 1024, 1024, 32, 24, C.G, C.bid};
              for (int rp = 0; rp < PB(1); ++rp) gemm_run_fp8(C, S, EpiBf16{WSP(bf16, O_PROJ), PROJ_N, PX_GATE, 1.0f / (F8_WSCALE * F8_XSCALE)}); }
#else
            PlainSched S{WSP(bf16, O_HN), WSP(bf16, O_WIN + l * SZ_WIN), 2048, 2048, 2048, 32, PROJ_N / 256, C.G, C.bid};
            for (int rp = 0; rp < PB(1); ++rp) gemm_run(C, S, EpiBf16{WSP(bf16, O_PROJ), PROJ_N, 0, 1.0f});
#endif
            SEAM(p0 + LP_INPROJ);
        }
        if (IN(p0 + LP_POST)) {
            PHASE_LOCALS;
            for (int rp = 0; rp < PB(2); ++rp) postproj_tokens(C, WSP(bf16, O_PROJ), (const int*)ka->in[2], INF(5) + l * 4096, INF(6) + l * 1024, INF(12) + l * 128, INF(13) + l * 128, INF(14) + l * 768, INF(15) + l * 512,
                            WSP(bf16, O_XC), WSP(bf16, O_QS), WSP(bf16, O_KS), WSP(bf16, O_QI), WSP(bf16, O_KI), WSP(bf16, O_CQN), WSP(bf16, O_CKVN));
            for (int rp = 0; rp < PB(3); ++rp) transpose_v(C, WSP(bf16, O_PROJ), PROJ_N, PX_AV, 128, WSP(bf16, O_VTS));
            SEAM(p0 + LP_POST);
        }
        if (IN(p0 + LP_MID1)) {
#ifndef SUBSEL
#define SUBSEL 15
#endif
            if (SUBSEL & 1) { PHASE_LOCALS; LruSched S{WSP(bf16, O_XC), WSP(bf16, O_WLRU + l * SZ_WLRU), 1024, 256, 256, C.G, C.bid};
              for (int rp = 0; rp < PB(4); ++rp) gemm_run(C, S, EpiLru{WSP(bf16, O_LA), WSP(bf16, O_LB), WSP(bf16, O_XC), INF(8) + l * 1024, INF(10) + l * 1024, (const float*)(WSP(int, O_MOEI) + MI_SP8) + l * 1024}); }
            if (SUBSEL & 2) { PHASE_LOCALS; PlainSched S{WSP(bf16, O_CQN), WSP(bf16, O_WUQ + l * SZ_WUQ), 768, 768, 768, 32, 6, C.G, C.bid}; for (int rp = 0; rp < PB(5); ++rp) gemm_run(C, S, EpiBf16{WSP(bf16, O_QMR), 1536, 0, 1.0f}); }
            if (SUBSEL & 4) { PHASE_LOCALS; PlainSched S{WSP(bf16, O_CKVN), WSP(bf16, O_WUKV + l * SZ_WUKV), 512, 512, 512, 32, 8, C.G, C.bid}; for (int rp = 0; rp < PB(5); ++rp) gemm_run(C, S, EpiBf16{WSP(bf16, O_KVMR), 2048, 0, 1.0f}); }
            if (SUBSEL & 8) { PHASE_LOCALS;
#if FAST_IDX
              for (int rp = 0; rp < PB(6); ++rp) indexer_mfma(C, WSP(bf16, O_PROJ), WSP(bf16, O_QI), WSP(bf16, O_KI), WSP(u64, O_SEL));
#else
              indexer_naive(C, WSP(bf16, O_PROJ), WSP(bf16, O_QI), WSP(bf16, O_KI), WSP(u64, O_SEL));
#endif
            }
            SEAM(p0 + LP_MID1);
        }
        if (IN(p0 + LP_MID2)) {
            { PHASE_LOCALS; for (int rp = 0; rp < PB(7); ++rp) lru_scan(C, WSP(bf16, O_LA), WSP(bf16, O_LB), WSP(bf16, O_PROJ), WSP(bf16, O_BR)); }
            { PHASE_LOCALS; for (int rp = 0; rp < PB(8); ++rp) mla_post(C, WSP(bf16, O_PROJ), (const int*)ka->in[2], WSP(bf16, O_QMR), WSP(bf16, O_KVMR), INF(18) + l * 192, INF(19) + l * 192, WSP(bf16, O_QM), WSP(bf16, O_KM));
              for (int rp = 0; rp < PB(8); ++rp) transpose_v(C, WSP(bf16, O_KVMR), 2048, 128, 256, WSP(bf16, O_VTM)); }
            { PHASE_LOCALS;
#if FAST_ATTN_S
              for (int rp = 0; rp < PB(9); ++rp) attn_mfma<128, true>(C, WSP(bf16, O_QS), WSP(bf16, O_KS), WSP(bf16, O_VTS), WSP(u64, O_SEL), WSP(bf16, O_BR) + (size_t)M * 1024);
#else
              sparse_attn_naive(C, WSP(bf16, O_PROJ), WSP(bf16, O_QS), WSP(bf16, O_KS), WSP(u64, O_SEL), WSP(bf16, O_BR) + (size_t)M * 1024);
#endif
            }
            SEAM(p0 + LP_MID2);
        }
        if (IN(p0 + LP_MLAATT)) {
            PHASE_LOCALS;
#if FAST_ATTN_M
            for (int rp = 0; rp < PB(10); ++rp) attn_mfma<192, false>(C, WSP(bf16, O_QM), WSP(bf16, O_KM), WSP(bf16, O_VTM), nullptr, WSP(bf16, O_BR) + (size_t)2 * M * 1024);
#else
            mla_attn_naive(C, WSP(bf16, O_QM), WSP(bf16, O_KM), WSP(bf16, O_KVMR), WSP(bf16, O_BR) + (size_t)2 * M * 1024);
#endif
            SEAM(p0 + LP_MLAATT);
        }
        if (IN(p0 + LP_BRANCH)) {
            PHASE_LOCALS;
            BranchSched S{WSP(bf16, O_BR), WSP(bf16, O_WBR + (size_t)l * 3 * SZ_WBR), 1024, 1024, 1024, C.G, C.bid};
            for (int rp = 0; rp < PB(11); ++rp) gemm_run(C, S, EpiBranch{WSP(bf16, O_PROJ), WSP(bf16, O_MF), WSP(bf16, O_MG)});
            SEAM(p0 + LP_BRANCH);
        }
        if (IN(p0 + LP_WOUT)) {
            PHASE_LOCALS;
            PlainSched S{WSP(bf16, O_MG), WSP(bf16, O_WOUT + l * SZ_WOUT), 2048, 2048, 2048, 32, 8, C.G, C.bid};
            if constexpr (l == 0) gemm_run(C, S, EpiResidT<false, true>{INF(0), WSP(bf16, O_H), D, 1.0f});
            else gemm_run(C, S, EpiResidT<true, true>{WSP(bf16, O_H), WSP(bf16, O_H), D, 1.0f});
            SEAM(p0 + LP_WOUT);
        }
        if (IN(p0 + LP_NORM2)) {
            PHASE_LOCALS; int* mi = WSP(int, O_MOEI);
            for (int rp = 0; rp < PB(12); ++rp)
            if (l == 0) rmsnorm_rows<false, (FP8_DENSE != 0) ? 1 : 0>(C, WSP(bf16, O_H), INF(22) + l * D, WSP(bf16, O_HN), nullptr, nullptr, nullptr);
            else rmsnorm_rows<true>(C, WSP(bf16, O_H), INF(22) + l * D, WSP(bf16, O_HN), INF(26), mi + MI_TOKE, (float*)(mi + MI_TOKG));
            SEAM(p0 + LP_NORM2);
        }
        if (l == 0) {
            if (IN(p0 + LP_FFN1)) {
                PHASE_LOCALS;
#if FP8_DENSE
                PlainSched S{WSP(bf16, O_HN), WSP(bf16, O_WD1), 1024, 1024, 1024, 32, 2 * DFF / 256, C.G, C.bid};
                for (int rp = 0; rp < PB(13); ++rp) gemm_run_fp8(C, S, EpiSwigluF8{WSP(unsigned char, O_HMID), DFF, 1.0f / (F8_WSCALE * F8_XSCALE)});
#else
                PlainSched S{WSP(bf16, O_HN), WSP(bf16, O_WD1), 2048, 2048, 2048, 32, 2 * DFF / 256, C.G, C.bid};
                for (int rp = 0; rp < PB(13); ++rp) gemm_run(C, S, EpiSwiglu{WSP(bf16, O_HMID), DFF});
#endif
                SEAM(p0 + LP_FFN1);
            }
            if (IN(p0 + LP_FFN2)) {
                PHASE_LOCALS;
#if FP8_DENSE
                PlainSched S{WSP(bf16, O_HMID), WSP(bf16, O_WD2), DFF / 2, DFF / 2, DFF / 2, 32, 8, C.G, C.bid};
                gemm_run_fp8(C, S, EpiResidT<true, true>{WSP(bf16, O_H), WSP(bf16, O_H), D, 1.0f / (F8_WSCALE * F8_HSCALE)});
#else
                PlainSched S{WSP(bf16, O_HMID), WSP(bf16, O_WD2), DFF, DFF, DFF, 32, 8, C.G, C.bid};
                gemm_run(C, S, EpiResidT<true, true>{WSP(bf16, O_H), WSP(bf16, O_H), D, 1.0f});
#endif
                SEAM(p0 + LP_FFN2);
            }
        } else {
            if (IN(p0 + LP_ROUTE)) { PHASE_LOCALS; for (int rp = 0; rp < PB(16); ++rp) moe_route(C, WSP(int, O_MOEI)); SEAM(p0 + LP_ROUTE); }
            if (IN(p0 + LP_GATHER)) { PHASE_LOCALS;
#if BG_CONV && FP8_MOE
              if (multi) bg_drain(lds0, bar.st, wave_s, ka);
#endif
              for (int rp = 0; rp < PB(16); ++rp)
#if FP8_MOE
                moe_gather_fp8(C, WSP(int, O_MOEI), WSP(bf16, O_HN), WSP(unsigned char, O_XS));
#else
                moe_gather(C, WSP(int, O_MOEI), WSP(bf16, O_HN), WSP(bf16, O_XS));
#endif
              SEAM(p0 + LP_GATHER); }
            if (IN(p0 + LP_FFN1)) {
                PHASE_LOCALS; int* mi = WSP(int, O_MOEI);
#if FP8_MOE
                MoeSched S{WSP(bf16, O_XS), WSP(bf16, O_WM1), 1024, 1024, 1024, 2 * EFF / 256, 4, 1, C.G, C.bid, mi + MI_BLKE, mi + MI_BSTART, mi[MI_NUSED], (size_t)EFF * 2048};
                for (int rp = 0; rp < PB(14); ++rp) gemm_run_fp8(C, S, EpiSwigluF8{WSP(unsigned char, O_HMID), EFF, 1.0f / (F8_WSCALE * F8_XSCALE)});
#else
                MoeSched S{WSP(bf16, O_XS), WSP(bf16, O_WM1), 2048, 2048, 2048, 2 * EFF / 256, 4, 1, C.G, C.bid, mi + MI_BLKE, mi + MI_BSTART, mi[MI_NUSED], (size_t)2 * EFF * 2048};
                for (int rp = 0; rp < PB(14); ++rp) gemm_run(C, S, EpiSwiglu{WSP(bf16, O_HMID), EFF});
#endif
                SEAM(p0 + LP_FFN1);
            }
            if (IN(p0 + LP_FFN2)) {
                PHASE_LOCALS; int* mi = WSP(int, O_MOEI);
#if FP8_MOE
                MoeSched S{WSP(bf16, O_HMID), WSP(bf16, O_WM2), EFF / 2, EFF / 2, EFF / 4, 8, 8, 2, C.G, C.bid, mi + MI_BLKE, mi + MI_BSTART, mi[MI_NUSED], (size_t)1024 * EFF};
                for (int rp = 0; rp < PB(15); ++rp) gemm_run_fp8(C, S, EpiScaleRow{WSP(bf16, O_YS), (const float*)(mi + MI_ROWG), 1.0f / (F8_WSCALE * F8_HSCALE)});
#else
                MoeSched S{WSP(bf16, O_HMID), WSP(bf16, O_WM2), EFF, EFF, EFF / 2, 8, 8, 2, C.G, C.bid, mi + MI_BLKE, mi + MI_BSTART, mi[MI_NUSED], (size_t)2048 * EFF};
                for (int rp = 0; rp < PB(15); ++rp) gemm_run(C, S, EpiScaleRow{WSP(bf16, O_YS), (const float*)(mi + MI_ROWG), 1.0f});
#endif
                SEAM(p0 + LP_FFN2);
            }
        }
        if (IN(p0 + LP_NORM3)) {
            { PHASE_LOCALS;
              if (l == 1) { moe_combine(C, WSP(int, O_MOEI), WSP(bf16, O_YS), WSP(bf16, O_H)); asm volatile("s_waitcnt vmcnt(0)" ::: "memory"); }
              rmsnorm_rows<false>(C, WSP(bf16, O_H), INF(30) + l * D, WSP(bf16, O_HN), nullptr, nullptr, nullptr); }
            { PHASE_LOCALS; PlainSched S{WSP(bf16, O_PBF + l * SZ_PBF), WSP(bf16, O_WPP + l * SZ_WPP), 256, 256, 256, 32, 8, C.G, C.bid}; for (int rp = 0; rp < PB(17); ++rp) gemm_run(C, S, EpiBf16{WSP(bf16, O_PP), D, 0, 1.0f}); }
            SEAM(p0 + LP_NORM3);
        }
        if (IN(p0 + LP_PLE)) {
            PHASE_LOCALS;
            PlainSched S{WSP(bf16, O_HN), WSP(bf16, O_WPG + l * SZ_WPG), 2048, 2048, 2048, 32, 8, C.G, C.bid};
            if constexpr (l == 1) gemm_run(C, S, EpiPleT<false>{WSP(bf16, O_H), ka->out, WSP(bf16, O_PP)});
            else gemm_run(C, S, EpiPleT<true>{WSP(bf16, O_H), WSP(bf16, O_H), WSP(bf16, O_PP)});
            SEAM(p0 + LP_PLE);
        }
        if (l == 0 && IN(p0 + LP_NORM1)) {
            PHASE_LOCALS;
            rmsnorm_rows<false, FP8_GATES ? 2 : 0>(C, WSP(bf16, O_H), INF(3) + D, WSP(bf16, O_HN), nullptr, nullptr, nullptr, WSP(unsigned char, O_HN8));
            SEAM(p0 + LP_NORM1);
        }
}

__global__ void __launch_bounds__(512, 2) mk_fwd(Args a) {
    extern __shared__ __attribute__((aligned(16))) unsigned char lds_raw[];
    LAS unsigned char* const lds0 = (LAS unsigned char*)lds_raw;
    volatile LAS unsigned* MISC = (volatile LAS unsigned*)(lds0 + LDS_MISC);
    const int wave_s = __builtin_amdgcn_readfirstlane((int)threadIdx.x >> 6);
    if (threadIdx.x < 16) MISC[threadIdx.x] = 0u;
    __syncthreads();
    const int lo = a.ph_lo, hi = a.ph_hi;
    XcdBarrier bar; bar.bar = (unsigned*)(a.ws) + CW_BAR; bar.x = 0; bar.st = MISC; bar.wave = wave_s;
    const bool multi = (hi - lo) > 1;
    if (multi) bar = xcd_barrier_post((unsigned*)(a.ws) + CW_BAR, MISC, wave_s);

    if (IN(0)) {
        PHASE_LOCALS;
        for (int rp = 0; rp < PB(0); ++rp) {
        for (int l = 0; l < 2; ++l) {
#if FP8_GATES
            conv_job(C, WSP(bf16, O_WIN + l * SZ_WIN), PX_GATE, 2048, 13712, RsWin{INF(4) + (size_t)l * 2048 * 13712});
            conv_job_fp8(C, WSP(unsigned char, O_WIN + l * SZ_WIN + (size_t)PX_GATE * 2048 * 2), 6144, 2048, 13712, RsPlain{INF(4) + (size_t)l * 2048 * 13712 + 7568}, F8_WSCALE);
#else
            conv_job(C, WSP(bf16, O_WIN + l * SZ_WIN), PROJ_N, 2048, 13712, RsWin{INF(4) + (size_t)l * 2048 * 13712});
#endif
            conv_job(C, WSP(bf16, O_WUQ + l * SZ_WUQ), 1536, 768, 1536, RsPlain{INF(16) + (size_t)l * 768 * 1536});
            conv_job(C, WSP(bf16, O_WUKV + l * SZ_WUKV), 2048, 512, 2048, RsPlain{INF(17) + (size_t)l * 512 * 2048});
            for (int n = 0; n < 3; ++n) conv_job(C, WSP(bf16, O_WBR + (l * 3 + n) * SZ_WBR), 2048, 1024, 2048, RsPlain{INF(20) + (size_t)(l * 3 + n) * 1024 * 2048});
            conv_job(C, WSP(bf16, O_WOUT + l * SZ_WOUT), 2048, 2048, 2048, RsPlain{INF(21) + (size_t)l * 2048 * 2048});
            conv_job(C, WSP(bf16, O_WPG + l * SZ_WPG), 2048, 2048, 2048, RsPlain{INF(31) + (size_t)l * 2048 * 2048});
            conv_job(C, WSP(bf16, O_WPP + l * SZ_WPP), 2048, 256, 2048, RsPlain{INF(32) + (size_t)l * 256 * 2048});
            { bf16* dst = WSP(bf16, O_WLRU + l * SZ_WLRU); const float* wa = INF(7) + (size_t)l * 8 * 128 * 128; const float* wx = INF(9) + (size_t)l * 8 * 128 * 128;
              for (int i = C.bid * 512 + C.tid; i < 2048 * 256; i += C.G * 512) { const int n = i >> 8, k = i & 255, pn = n >> 8, r = n & 255, gt = r >> 7, d = r & 127, kb = k >> 7, cc = k & 127;
                  const bool on = (2 * (pn >> 1) + kb) == pn; const float wv = (wa + (gt ? (wx - wa) : (ptrdiff_t)0))[(size_t)(pn * 128 + cc) * 128 + d]; dst[i] = on ? f2bf(wv) : (bf16)0; } }
        }
#if FP8_DENSE
        conv_job_fp8(C, WSP(unsigned char, O_WD1), 2 * DFF, 2048, DFF, RsGU{INF(23), INF(24) - INF(23)}, F8_WSCALE);
        conv_job_fp8(C, WSP(unsigned char, O_WD2), 2048, DFF, 2048, RsPlain{INF(25)}, F8_WSCALE);
#else
        conv_job(C, WSP(bf16, O_WD1), 2 * DFF, 2048, DFF, RsGU{INF(23), INF(24) - INF(23)});
        conv_job(C, WSP(bf16, O_WD2), 2048, DFF, 2048, RsPlain{INF(25)});
#endif
        for (int e = 0; e < ((BG_CONV && FP8_MOE && multi) ? 0 : 8); ++e) {
#if FP8_MOE
            conv_job_fp8(C, WSP(unsigned char, O_WM1 + e * (SZ_WM1 / 2)), 2 * EFF, 2048, EFF, RsGU{INF(27) + (size_t)e * 2048 * EFF, INF(28) - INF(27)}, F8_WSCALE);
            conv_job_fp8(C, WSP(unsigned char, O_WM2 + e * (SZ_WM2 / 2)), 2048, EFF, 2048, RsPlain{INF(29) + (size_t)e * EFF * 2048}, F8_WSCALE);
#else
            conv_job(C, WSP(bf16, O_WM1 + e * SZ_WM1), 2 * EFF, 2048, EFF, RsGU{INF(27) + (size_t)e * 2048 * EFF, INF(28) - INF(27)});
            conv_job(C, WSP(bf16, O_WM2 + e * SZ_WM2), 2048, EFF, 2048, RsPlain{INF(29) + (size_t)e * EFF * 2048});
#endif
        }
        { float* sp8 = (float*)(WSP(int, O_MOEI) + MI_SP8); const float* lam = INF(11); for (int i = C.bid * 512 + C.tid; i < 2048; i += C.G * 512) sp8[i] = 8.0f * log1pf(__expf(-lam[i])); }
        { bf16* pb = WSP(bf16, O_PBF); const float* p = INF(1); for (size_t i = (size_t)C.bid * 512 + C.tid; i < (size_t)2 * M * 256 / 4; i += (size_t)C.G * 512) { const f32x4 v = ((const f32x4*)p)[i]; u32x2 w; w.x = pk2(v[0], v[1]); w.y = pk2(v[2], v[3]); ((u32x2*)pb)[i] = w; } }
        rmsnorm_rows<false, FP8_GATES ? 2 : 0, false>(C, INF(0), INF(3), WSP(bf16, O_HN), nullptr, nullptr, nullptr, WSP(unsigned char, O_HN8));
        }
        SEAM(0);
    }

    layer_body<0>(lo, hi, multi, bar, lds0, wave_s);
    layer_body<1>(lo, hi, multi, bar, lds0, wave_s);
#undef IN
#undef SEAM
#undef INF
}

extern "C" void kernel_launch(void* const* d_in, const int* in_sizes, int n_in, void* d_out, int out_size, void* d_ws, size_t ws_size, hipStream_t stream) {
    static int grid = 0;
    if (grid == 0) {
        if (n_in != 33 || out_size != M * D || ws_size < WS_END) { fprintf(stderr, "kernel_launch: unexpected problem (n_in %d, out %d, ws %zu < %zu)\n", n_in, out_size, ws_size, (size_t)WS_END); grid = -1; return; }
        int dev = 0, cus = 0, per_cu = 0;
        if (hipGetDevice(&dev) != hipSuccess || hipDeviceGetAttribute(&cus, hipDeviceAttributeMultiprocessorCount, dev) != hipSuccess) { grid = -1; return; }
        if (hipFuncSetAttribute((const void*)mk_fwd, hipFuncAttributeMaxDynamicSharedMemorySize, LDS_BYTES) != hipSuccess) { fprintf(stderr, "kernel_launch: hipFuncSetAttribute failed\n"); grid = -1; return; }
        if (hipOccupancyMaxActiveBlocksPerMultiprocessor(&per_cu, (const void*)mk_fwd, 512, LDS_BYTES) != hipSuccess || per_cu < 1) fprintf(stderr, "kernel_launch: occupancy query says %d\n", per_cu);
        (void)hipGetLastError();
        grid = cus;
    }
    if (grid < 0) return;
    (void)hipMemsetAsync(d_ws, 0, CTL_BYTES, stream);
    Args a{};
    for (int i = 0; i < 33; ++i) a.in[i] = d_in[i];
    a.out = (float*)d_out; a.ws = (unsigned char*)d_ws;
#if N_LAUNCH_MODE == 1
    a.ph_lo = 0; a.ph_hi = NPH;
    hipLaunchKernelGGL(mk_fwd, dim3(grid), dim3(512), LDS_BYTES, stream, a);
#else
    for (int ph = 0; ph < NPH; ++ph) { if (!phase_active(ph)) continue; a.ph_lo = ph; a.ph_hi = ph + 1; hipLaunchKernelGGL(mk_fwd, dim3(grid), dim3(512), LDS_BYTES, stream, a); }
#endif
}
```

```cpp
#include <hip/hip_runtime.h>
#include <cstdio>
#include <cstdint>

#ifndef FAST_GEMM
#define FAST_GEMM 1
#endif
#ifndef FAST_CONV
#define FAST_CONV 1
#endif
#ifndef FAST_ATTN_S
#define FAST_ATTN_S 1
#endif
#ifndef FAST_ATTN_M
#define FAST_ATTN_M 1
#endif
#ifndef FAST_IDX
#define FAST_IDX 1
#endif
#ifndef PROBE_ID
#define PROBE_ID -1
#endif
#define PB(id) ((PROBE_ID == (id)) ? 2 : 1)
#ifndef FP8_MOE
#define FP8_MOE 1
#endif
#ifndef FP8_DENSE
#define FP8_DENSE 1
#endif
#ifndef FP8_GATES
#define FP8_GATES 1
#endif
#ifndef BG_NOWAITWORK
#define BG_NOWAITWORK 0
#endif
#ifndef BG_CONV
#define BG_CONV 1
#endif
#ifndef N_LAUNCH_MODE
#define N_LAUNCH_MODE 1
#endif

#define LAS __attribute__((address_space(3)))
typedef unsigned short bf16;
typedef short bf16x8 __attribute__((ext_vector_type(8)));
typedef float f32x4 __attribute__((ext_vector_type(4)));
typedef unsigned u32x4 __attribute__((ext_vector_type(4)));
typedef unsigned u32x2 __attribute__((ext_vector_type(2)));
typedef unsigned long long u64;

constexpr int NB = 4, T = 2048, M = NB * T, D = 2048;
constexpr int PROJ_N = 13824;
constexpr int PX_LRUX = 0, PX_LRUG = 1024, PX_AQ = 2048, PX_AK = 3072, PX_AV = 4096, PX_IQ = 5120, PX_CQ = 6144, PX_CKV = 6912, PX_IK = 7424, PX_KR = 7488, PX_IW = 7552, PX_GATE = 7680;
constexpr int DFF = 5632, EFF = 7168, NEXP = 8, MOE_ROWS = 18432, MOE_BLKS = 72;
constexpr float EPS = 1e-6f;
constexpr float LOG2_THETA = 13.287712379549449f;
constexpr float INV_2PI = 0.15915494309189535f;

constexpr size_t CTL_BYTES = 1u << 20;
constexpr size_t SZ_WIN = (size_t)PROJ_N * 2048 * 2, SZ_WLRU = (size_t)2048 * 256 * 2, SZ_WUQ = (size_t)1536 * 768 * 2, SZ_WUKV = (size_t)2048 * 512 * 2,
                 SZ_WBR = (size_t)2048 * 1024 * 2, SZ_WOUT = (size_t)2048 * 2048 * 2, SZ_WD1 = (size_t)2 * DFF * 2048 * 2, SZ_WD2 = (size_t)2048 * DFF * 2,
                 SZ_WM1 = (size_t)2 * EFF * 2048 * 2, SZ_WM2 = (size_t)2048 * EFF * 2, SZ_WPG = (size_t)2048 * 2048 * 2, SZ_WPP = (size_t)2048 * 256 * 2, SZ_PBF = (size_t)M * 256 * 2;
constexpr size_t O_WIN = CTL_BYTES;
constexpr size_t O_WLRU = O_WIN + 2 * SZ_WIN;
constexpr size_t O_WUQ = O_WLRU + 2 * SZ_WLRU;
constexpr size_t O_WUKV = O_WUQ + 2 * SZ_WUQ;
constexpr size_t O_WBR = O_WUKV + 2 * SZ_WUKV;
constexpr size_t O_WOUT = O_WBR + 6 * SZ_WBR;
constexpr size_t O_WD1 = O_WOUT + 2 * SZ_WOUT;
constexpr size_t O_WD2 = O_WD1 + SZ_WD1;
constexpr size_t O_WM1 = O_WD2 + SZ_WD2;
constexpr size_t O_WM2 = O_WM1 + 8 * SZ_WM1;
constexpr size_t O_WPG = O_WM2 + 8 * SZ_WM2;
constexpr size_t O_WPP = O_WPG + 2 * SZ_WPG;
constexpr size_t O_PBF = O_WPP + 2 * SZ_WPP;
constexpr size_t O_H = O_PBF + 2 * SZ_PBF;
constexpr size_t O_HN = O_H + (size_t)M * D * 4;
constexpr size_t O_PP = O_HN + (size_t)M * D * 2;
constexpr size_t O_MOEI = O_PP + (size_t)M * D * 2;
constexpr size_t O_HN8 = O_MOEI + (1u << 20);
constexpr size_t O_SCR = O_HN8 + (size_t)M * D;
constexpr size_t O_PROJ = O_SCR;
constexpr size_t O_XC = O_PROJ + (size_t)M * PROJ_N * 2;
constexpr size_t O_LA = O_XC + (size_t)M * 1024 * 2;
constexpr size_t O_LB = O_LA + (size_t)M * 1024 * 4;
constexpr size_t O_BR = O_LB + (size_t)M * 1024 * 4;
constexpr size_t O_QS = O_BR + (size_t)3 * M * 1024 * 2;
constexpr size_t O_KS = O_QS + (size_t)M * 1024 * 2;
constexpr size_t O_VTS = O_KS + (size_t)M * 1024 * 2;
constexpr size_t O_QI = O_VTS + (size_t)M * 1024 * 2;
constexpr size_t O_KI = O_QI + (size_t)M * 1024 * 2;
constexpr size_t O_SEL = O_KI + (size_t)M * 64 * 2;
constexpr size_t O_CQN = O_SEL + (size_t)M * 32 * 8;
constexpr size_t O_CKVN = O_CQN + (size_t)M * 768 * 2;
constexpr size_t O_QMR = O_CKVN + (size_t)M * 512 * 2;
constexpr size_t O_KVMR = O_QMR + (size_t)M * 1536 * 2;
constexpr size_t O_QM = O_KVMR + (size_t)M * 2048 * 2;
constexpr size_t O_KM = O_QM + (size_t)M * 1536 * 2;
constexpr size_t O_VTM = O_KM + (size_t)M * 1536 * 2;
constexpr size_t O_MF = O_VTM + (size_t)M * 1024 * 2;
constexpr size_t O_MG = O_MF + (size_t)M * D * 4;
constexpr size_t O_MIXEND = O_MG + (size_t)M * D * 2;
constexpr size_t O_HMID = O_SCR;
constexpr size_t O_XS = O_HMID + (size_t)MOE_ROWS * EFF * 2;
constexpr size_t O_YS = O_XS + (size_t)MOE_ROWS * D * 2;
constexpr size_t O_FFNEND = O_YS + (size_t)2 * MOE_ROWS * D * 4;
constexpr size_t WS_END = O_MIXEND > O_FFNEND ? O_MIXEND : O_FFNEND;
static_assert(WS_END <= 1998027776ull, "workspace map exceeds the guaranteed d_ws size");
static_assert((O_H % 256) == 0 && (O_SCR % 256) == 0 && (O_XC % 256) == 0, "alignment");
constexpr int MI_TOKE = 0;
constexpr int MI_TOKG = MI_TOKE + 2 * M;
constexpr int MI_DEST = MI_TOKG + 2 * M;
constexpr int MI_ROWTOK = MI_DEST + 2 * M;
constexpr int MI_ROWG = MI_ROWTOK + MOE_ROWS;
constexpr int MI_BLKE = MI_ROWG + MOE_ROWS;
constexpr int MI_NUSED = MI_BLKE + 128;
constexpr int MI_BSTART = MI_NUSED + 16;
constexpr int MI_SP8 = MI_BSTART + 64;
static_assert((MI_SP8 + 2048) * 4 <= (1 << 20), "moe tables");

#define XB_TMO      128
#define XB_XCNT(j)  (256  + 64 * (j))
#define XB_XSUB(j)  (1280 + 64 * (j))
#define XB_XGEN(j)  (2304 + 64 * (j))
#define XB_TOP      3328
#define XB_TOPGEN   3392
#define XCD_BAR_WORDS 3456
#define XB_SPIN_CAP (1u << 18)
constexpr int CW_BAR = 4096;

constexpr int LDS_RING = 131072, LDS_MISC = LDS_RING + 256, LDS_BYTES = 147456;

__device__ __forceinline__ unsigned pk2(float lo, float hi) { unsigned r; asm("v_cvt_pk_bf16_f32 %0, %1, %2" : "=v"(r) : "v"(lo), "v"(hi)); return r; }
__device__ __forceinline__ bf16 f2bf(float f) { return (bf16)(pk2(f, 0.f) & 0xffffu); }
__device__ __forceinline__ float bf2f(bf16 b) { return __builtin_bit_cast(float, (unsigned)b << 16); }
__device__ __forceinline__ float bflo(unsigned w) { return __builtin_bit_cast(float, w << 16); }
__device__ __forceinline__ float bfhi(unsigned w) { return __builtin_bit_cast(float, w & 0xffff0000u); }
__device__ __forceinline__ unsigned pk4_fp8(float a, float b, float c, float d) { int p = 0; p = __builtin_amdgcn_cvt_pk_fp8_f32(a, b, p, false); p = __builtin_amdgcn_cvt_pk_fp8_f32(c, d, p, true); return (unsigned)p; }
constexpr float F8_WSCALE = 512.f, F8_XSCALE = 16.f, F8_HSCALE = 8.f;
__device__ __forceinline__ float wave_sum(float v) {
#pragma unroll
    for (int o = 1; o < 64; o <<= 1) v += __shfl_xor(v, o);
    return v;
}
__device__ __forceinline__ int wave_sum_i(int v) {
    v += __builtin_amdgcn_update_dpp(0, v, 0x111, 0xf, 0xf, true);
    v += __builtin_amdgcn_update_dpp(0, v, 0x112, 0xf, 0xf, true);
    v += __builtin_amdgcn_update_dpp(0, v, 0x114, 0xf, 0xf, true);
    v += __builtin_amdgcn_update_dpp(0, v, 0x118, 0xf, 0xf, true);
    return __builtin_amdgcn_readlane(v, 15) + __builtin_amdgcn_readlane(v, 31) + __builtin_amdgcn_readlane(v, 47) + __builtin_amdgcn_readlane(v, 63);
}
__device__ __forceinline__ float wave_max(float v) {
#pragma unroll
    for (int o = 1; o < 64; o <<= 1) v = fmaxf(v, __shfl_xor(v, o));
    return v;
}
__device__ __forceinline__ float relu_(float x) { return __builtin_amdgcn_fmed3f(x, 0.f, __builtin_inff()); }
__device__ __forceinline__ float sigmoidf_(float x) { return __builtin_amdgcn_rcpf(1.0f + __expf(-x)); }
__device__ __forceinline__ float gelu_tanh(float x) { const float z = 0.7978845608028654f * (x + 0.044715f * x * x * x); const float e = __expf(2.0f * z); return x * (1.0f - __builtin_amdgcn_rcpf(1.0f + e)); }
__device__ __forceinline__ float rd_lane(float v, int l) { return __builtin_bit_cast(float, __builtin_amdgcn_readlane(__builtin_bit_cast(int, v), l)); }
__device__ __forceinline__ unsigned rd_lane_u(unsigned v, int l) { return (unsigned)__builtin_amdgcn_readlane((int)v, l); }

__device__ __forceinline__ unsigned xb_ld(unsigned* p)              { return __hip_atomic_load(p, __ATOMIC_RELAXED, __HIP_MEMORY_SCOPE_AGENT); }
__device__ __forceinline__ unsigned xb_add(unsigned* p, unsigned v) { return __hip_atomic_fetch_add(p, v, __ATOMIC_RELAXED, __HIP_MEMORY_SCOPE_AGENT); }
__device__ __forceinline__ unsigned xb_xcc_id() { return (unsigned)__builtin_amdgcn_s_getreg((3 << 11) | 20) & 0xFu; }
#define XB_SPIN(cond, bar) do { unsigned _sp = 0; while (cond) { __builtin_amdgcn_s_sleep(1); \
    if ((++_sp & 255u) == 0u) { if (xb_ld(&(bar)[XB_TMO])) break; if (_sp > XB_SPIN_CAP) { atomicAdd(&(bar)[XB_TMO], 1u); break; } } } } while (0)
struct XcdBarrier { unsigned* bar; unsigned x; volatile LAS unsigned* st; int wave; };
__device__ __forceinline__ bool xb_thread0(int wave) { return wave == 0 && __builtin_amdgcn_mbcnt_hi(~0u, __builtin_amdgcn_mbcnt_lo(~0u, 0u)) == 0u; }
__device__ __forceinline__ XcdBarrier xcd_barrier_post(unsigned* bar, volatile LAS unsigned* st, int wave) {
    XcdBarrier b; b.bar = bar; b.x = xb_xcc_id(); b.st = st; b.wave = wave;
    if (xb_thread0(wave)) (void)xb_add(&bar[XB_XCNT(b.x)], 1u);
    return b;
}
__device__ __forceinline__ void xcd_barrier_complete(unsigned* bar, unsigned x, unsigned& nloc, unsigned& nx) {
    const unsigned G = gridDim.x * gridDim.y * gridDim.z;
    unsigned sum, cnt, mine, sp = 0u;
    for (;;) {
        sum = 0u; cnt = 0u; mine = 0u;
#pragma unroll
        for (unsigned j = 0; j < 16; ++j) { const unsigned c = xb_ld(&bar[XB_XCNT(j)]); sum += c; cnt += (c > 0u) ? 1u : 0u; mine = (j == x) ? c : mine; }
        if (sum == G) break;
        __builtin_amdgcn_s_sleep(1);
        if ((++sp & 255u) == 0u) { if (xb_ld(&bar[XB_TMO])) break; if (sp > XB_SPIN_CAP) { atomicAdd(&bar[XB_TMO], 1u); break; } }
    }
    nloc = mine > 0u ? mine : 1u; nx = cnt > 0u ? cnt : 1u;
}
__device__ __forceinline__ void xcd_barrier(const XcdBarrier& b) {
    asm volatile("s_waitcnt vmcnt(0)" ::: "memory");
    __syncthreads();
    if (xb_thread0(b.wave)) {
        unsigned* bar = b.bar; unsigned bx = b.x;
        asm volatile("" : "+s"(bar), "+s"(bx));
        __builtin_amdgcn_s_waitcnt(0);
        unsigned nloc = b.st[0], nx = b.st[1];
        if (nloc == 0u) { xcd_barrier_complete(bar, bx, nloc, nx); b.st[0] = nloc; b.st[1] = nx; }
        const unsigned old = xb_add(&bar[XB_XSUB(bx)], 1u);
        const unsigned gen = old / nloc;
        if (old + 1u == (gen + 1u) * nloc) {
            __builtin_amdgcn_fence(__ATOMIC_RELEASE, "agent");
            asm volatile("s_waitcnt vmcnt(0)" ::: "memory");
            const unsigned og = xb_add(&bar[XB_TOP], 1u);
            const unsigned tg = og / nx;
            if (og + 1u == (tg + 1u) * nx) xb_add(&bar[XB_TOPGEN], 1u);
            else XB_SPIN(xb_ld(&bar[XB_TOPGEN]) == tg, bar);
            __builtin_amdgcn_fence(__ATOMIC_ACQUIRE, "agent");
            xb_add(&bar[XB_XGEN(bx)], 1u);
            asm volatile("s_waitcnt vmcnt(0)" ::: "memory");
        } else {
            XB_SPIN(xb_ld(&bar[XB_XGEN(bx)]) == gen, bar);
            __builtin_amdgcn_fence(__ATOMIC_ACQUIRE, "agent");
            asm volatile("s_waitcnt vmcnt(0)" ::: "memory");
        }
    }
    __syncthreads();
}

struct Args { const void* in[33]; float* out; unsigned char* ws; int ph_lo, ph_hi; };
struct Ctx {
    LAS unsigned char* lds; int tid, lane, wave, bid, G;
};
#define WSP(T_, off) ((T_*)(wsb + (off)))
typedef const __attribute__((address_space(4))) Args* KArgPtr;
__device__ __forceinline__ KArgPtr kargs() { KArgPtr p = (KArgPtr)__builtin_amdgcn_kernarg_segment_ptr(); asm volatile("" : "+s"(p)); return p; }
__device__ __forceinline__ Ctx make_ctx(LAS unsigned char* lds, int wave_s) { Ctx C; int w = wave_s; asm volatile("" : "+s"(w)); int ln; asm volatile("v_mbcnt_lo_u32_b32 %0, -1, 0\n\tv_mbcnt_hi_u32_b32 %0, -1, %0" : "=v"(ln)); C.lds = lds; C.lane = ln; C.wave = w; C.tid = w * 64 + ln; C.bid = blockIdx.x; C.G = gridDim.x; return C; }
#define PHASE_LOCALS __builtin_amdgcn_sched_barrier(0); KArgPtr ka = kargs(); unsigned char* const wsb = ka->ws; (void)wsb; Ctx C = make_ctx(lds0, wave_s)

struct Unit { int pm, pn, g, k; };
__device__ __forceinline__ bool static_tile(int i, int G, int c, int nM, int nN, int& pm, int& pn) {
    const int nwg = nM * nN; const long L = (long)i * G + c; if (L >= nwg) return false;
    int wgid = (int)L; { const int q = nwg / 8, r = nwg % 8, xcd = wgid % 8, off = wgid / 8; wgid = (xcd < r ? xcd * (q + 1) : r * (q + 1) + (xcd - r) * q) + off; }
    const int nig = 8 * nN, gid = wgid / nig, fm = gid * 8, gsz = (nM - fm) < 8 ? (nM - fm) : 8;
    pm = fm + ((wgid % nig) % gsz); pn = (wgid % nig) / gsz; return true;
}
struct PlainSched {
    const bf16* A; const bf16* Bt; int lda, ldb, K, nM, nN, G, c;
    __device__ __forceinline__ bool next(int i, Unit& u) const { u.g = 0; u.k = 0; return static_tile(i, G, c, nM, nN, u.pm, u.pn); }
    __device__ __forceinline__ const char* aptr(const Unit& u) const { return (const char*)(A + (size_t)u.pm * 256 * lda); }
    __device__ __forceinline__ const char* bptr(const Unit& u) const { return (const char*)(Bt + (size_t)u.pn * 256 * ldb); }
};
struct LruSched {
    const bf16* A; const bf16* Bt; int lda, ldb, K, G, c;
    __device__ __forceinline__ bool next(int i, Unit& u) const { u.g = 0; u.k = 0; return static_tile(i, G, c, 32, 8, u.pm, u.pn); }
    __device__ __forceinline__ const char* aptr(const Unit& u) const { return (const char*)(A + (size_t)u.pm * 256 * lda + 256 * (u.pn >> 1)); }
    __device__ __forceinline__ const char* bptr(const Unit& u) const { return (const char*)(Bt + (size_t)u.pn * 256 * ldb); }
};
struct BranchSched {
    const bf16* A; const bf16* Bt; int lda, ldb, K, G, c;
    __device__ __forceinline__ bool next(int i, Unit& u) const { const int tile = c + G * (i / 3); if (tile >= 256) return false; u.g = i % 3; u.k = 0;
        const int x = tile & 7, j = tile >> 3; u.pm = 4 * x + (j >> 3); u.pn = j & 7; return true; }
    __device__ __forceinline__ const char* aptr(const Unit& u) const { return (const char*)(A + ((size_t)u.g * M + (size_t)u.pm * 256) * lda); }
    __device__ __forceinline__ const char* bptr(const Unit& u) const { return (const char*)(Bt + ((size_t)u.g * 2048 + (size_t)u.pn * 256) * ldb); }
};
struct MoeSched {
    const bf16* A; const bf16* Bt; int lda, ldb, K, nN, GP, KS, G, c; const int* blke; const int* bstart; int nused; size_t estride;
    __device__ __forceinline__ bool next(int i, Unit& u) const {
        const int nwg = nused * nN * KS; const long L = (long)i * G + c; if (L >= nwg) return false;
        int p = (int)L; { const int q = nwg / 8, r = nwg % 8, xcd = p % 8, off = p / 8; p = (xcd < r ? xcd * (q + 1) : r * (q + 1) + (xcd - r) * q) + off; }
        int e = 0, b0 = 0, b1 = __builtin_amdgcn_readfirstlane(bstart[1]);
#pragma unroll
        for (int j = 1; j < 8; ++j) { const int bj = __builtin_amdgcn_readfirstlane(bstart[j]), bn = __builtin_amdgcn_readfirstlane(bstart[j + 1]); if (p >= bj * nN * KS) { e = j; b0 = bj; b1 = bn; } }
        const int nb = b1 - b0, qq = p - b0 * nN * KS, ks = qq / (nb * nN), q = qq - ks * (nb * nN), per = nb * GP, g4 = q / per, rem = q - g4 * per, bl = rem / GP, pl = rem - bl * GP;
        u.pm = b0 + bl; u.pn = g4 * GP + pl; u.g = e; u.k = ks; return true;
    }
    __device__ __forceinline__ const char* aptr(const Unit& u) const { return (const char*)(A + (size_t)u.pm * 256 * lda + (size_t)u.k * K); }
    __device__ __forceinline__ const char* bptr(const Unit& u) const { return (const char*)(Bt + (size_t)u.g * estride + (size_t)u.pn * 256 * ldb + (size_t)u.k * K); }
};

struct EpiNoCol { };
struct EpiBf16 { static constexpr bool DUAL = false, PRELOAD = false; bf16* O; int ldc; int coff; float sc;
    __device__ __forceinline__ void store(const Unit& u, int r, int c, f32x4 v) const {
        u32x2 w; w.x = pk2(v[0] * sc, v[1] * sc); w.y = pk2(v[2] * sc, v[3] * sc); *(u32x2*)(O + (size_t)(u.pm * 256 + r) * ldc + coff + u.pn * 256 + c) = w; } };
struct EpiLru { static constexpr bool DUAL = true, PRELOAD = true; bf16* la; bf16* lb; const bf16* xc; const float* ba; const float* bx; const float* sp8;
    struct Data { u32x2 xw; }; struct Col { f32x4 ba4, bx4, sp4; };
    __device__ __forceinline__ Col cload(const Unit& u, int c) const { const int col = u.pn * 128 + c; Col q; q.ba4 = *(const f32x4*)(ba + col); q.bx4 = *(const f32x4*)(bx + col); q.sp4 = *(const f32x4*)(sp8 + col); return q; }
    __device__ __forceinline__ Data load(const Unit& u, int r, int c) const { Data d; d.xw = *(const u32x2*)(xc + (size_t)(u.pm * 256 + r) * 1024 + u.pn * 128 + c); return d; }
    __device__ __forceinline__ void store2(const Unit& u, int r, int c, f32x4 g, f32x4 up, const Data& d, const Col& q) const {
        const int row = u.pm * 256 + r, col = u.pn * 128 + c; f32x4 a1, b;
        const float xv[4] = {bflo(d.xw.x), bfhi(d.xw.x), bflo(d.xw.y), bfhi(d.xw.y)};
#pragma unroll
        for (int j = 0; j < 4; ++j) { const float rr = sigmoidf_(g[j] + q.ba4[j]), ii = sigmoidf_(up[j] + q.bx4[j]);
            const float aa = __expf(-rr * q.sp4[j]); a1[j] = 1.0f - aa; b[j] = sqrtf(fmaxf(1.0f - aa * aa, 0.f)) * (ii * xv[j]); }
        u32x2 wa, wb; wa.x = pk2(a1[0], a1[1]); wa.y = pk2(a1[2], a1[3]); wb.x = pk2(b[0], b[1]); wb.y = pk2(b[2], b[3]);
        *(u32x2*)(la + (size_t)row * 1024 + col) = wa; *(u32x2*)(lb + (size_t)row * 1024 + col) = wb; }
    __device__ __forceinline__ void store2(const Unit& u, int r, int c, f32x4 g, f32x4 up) const { store2(u, r, c, g, up, load(u, r, c), cload(u, c)); } };
struct EpiBranch { static constexpr bool DUAL = false, PRELOAD = true; const bf16* proj; bf16* mf; bf16* mg;
    struct Data { u32x2 gw, pw; }; typedef EpiNoCol Col;
    __device__ __forceinline__ Col cload(const Unit&, int) const { return Col{}; }
    __device__ __forceinline__ Data load(const Unit& u, int r, int c) const { const int row = u.pm * 256 + r, col = u.pn * 256 + c; Data d;
        d.gw = *(const u32x2*)(proj + (size_t)row * PROJ_N + PX_GATE + u.g * 2048 + col); d.pw = (u32x2){0u, 0u}; if (u.g != 0) d.pw = *(const u32x2*)(mf + (size_t)row * D + col); return d; }
    __device__ __forceinline__ void store(const Unit& u, int r, int c, f32x4 v, const Data& d, const Col&) const {
        const int row = u.pm * 256 + r, col = u.pn * 256 + c;
        f32x4 o; o[0] = v[0] * sigmoidf_(bflo(d.gw.x)) + bflo(d.pw.x); o[1] = v[1] * sigmoidf_(bfhi(d.gw.x)) + bfhi(d.pw.x); o[2] = v[2] * sigmoidf_(bflo(d.gw.y)) + bflo(d.pw.y); o[3] = v[3] * sigmoidf_(bfhi(d.gw.y)) + bfhi(d.pw.y);
        u32x2 w; w.x = pk2(o[0], o[1]); w.y = pk2(o[2], o[3]);
        *(u32x2*)((u.g == 2 ? mg : mf) + (size_t)row * D + col) = w; }
    __device__ __forceinline__ void store(const Unit& u, int r, int c, f32x4 v) const { store(u, r, c, v, load(u, r, c), Col{}); } };
template <bool BIN, bool BOUT> struct EpiResidT { static constexpr bool DUAL = false, PRELOAD = true; const void* base; void* out; int ldc; float sc;
    struct Data { f32x4 bv; }; typedef EpiNoCol Col;
    __device__ __forceinline__ Col cload(const Unit&, int) const { return Col{}; }
    __device__ __forceinline__ Data load(const Unit& u, int r, int c) const { const size_t o = (size_t)(u.pm * 256 + r) * ldc + u.pn * 256 + c; Data d;
        if (BIN) { const u32x2 w = *(const u32x2*)((const bf16*)base + o); d.bv = (f32x4){bflo(w.x), bfhi(w.x), bflo(w.y), bfhi(w.y)}; } else d.bv = *(const f32x4*)((const float*)base + o); return d; }
    __device__ __forceinline__ void store(const Unit& u, int r, int c, f32x4 v, const Data& d, const Col&) const {
        const size_t o = (size_t)(u.pm * 256 + r) * ldc + u.pn * 256 + c; const f32x4 y = d.bv + v * sc;
        if (BOUT) { u32x2 w; w.x = pk2(y[0], y[1]); w.y = pk2(y[2], y[3]); *(u32x2*)((bf16*)out + o) = w; } else *(f32x4*)((float*)out + o) = y; }
    __device__ __forceinline__ void store(const Unit& u, int r, int c, f32x4 v) const { store(u, r, c, v, load(u, r, c), Col{}); } };
struct EpiSwiglu { static constexpr bool DUAL = true, PRELOAD = false; bf16* O; int ldo;
    __device__ __forceinline__ void store2(const Unit& u, int r, int c, f32x4 g, f32x4 up) const {
        f32x4 o;
#pragma unroll
        for (int j = 0; j < 4; ++j) o[j] = g[j] * sigmoidf_(g[j]) * up[j];
        u32x2 w; w.x = pk2(o[0], o[1]); w.y = pk2(o[2], o[3]); *(u32x2*)(O + (size_t)(u.pm * 256 + r) * ldo + u.pn * 128 + c) = w; } };
struct EpiSwigluF8 { static constexpr bool DUAL = true, PRELOAD = false; unsigned char* O; int ldo; float sin;
    __device__ __forceinline__ void store2(const Unit& u, int r, int c, f32x4 g, f32x4 up) const {
        f32x4 o;
#pragma unroll
        for (int j = 0; j < 4; ++j) { const float gg = g[j] * sin, uu = up[j] * sin; o[j] = gg * sigmoidf_(gg) * uu * F8_HSCALE; }
        *(unsigned*)(O + (size_t)(u.pm * 256 + r) * ldo + u.pn * 128 + c) = pk4_fp8(o[0], o[1], o[2], o[3]); } };
struct EpiScaleRow { static constexpr bool DUAL = false, PRELOAD = true; bf16* ys; const float* rowg; float sc;
    struct Data { float g; }; typedef EpiNoCol Col;
    __device__ __forceinline__ Col cload(const Unit&, int) const { return Col{}; }
    __device__ __forceinline__ Data load(const Unit& u, int r, int) const { Data d; d.g = rowg[u.pm * 256 + r]; return d; }
    __device__ __forceinline__ void store(const Unit& u, int r, int c, f32x4 v, const Data& d, const Col&) const {
        const int row = u.pm * 256 + r; const float gs = d.g * sc; u32x2 w; w.x = pk2(v[0] * gs, v[1] * gs); w.y = pk2(v[2] * gs, v[3] * gs);
        *(u32x2*)(ys + (size_t)u.k * MOE_ROWS * D + (size_t)row * D + u.pn * 256 + c) = w; }
    __device__ __forceinline__ void store(const Unit& u, int r, int c, f32x4 v) const { store(u, r, c, v, load(u, r, c), Col{}); } };
template <bool BOUT> struct EpiPleT { static constexpr bool DUAL = false, PRELOAD = true; const bf16* hin; void* hout; const bf16* pp;
    struct Data { u32x2 pw, hw; }; typedef EpiNoCol Col;
    __device__ __forceinline__ Col cload(const Unit&, int) const { return Col{}; }
    __device__ __forceinline__ Data load(const Unit& u, int r, int c) const { const size_t o = (size_t)(u.pm * 256 + r) * D + u.pn * 256 + c; Data d; d.pw = *(const u32x2*)(pp + o); d.hw = *(const u32x2*)(hin + o); return d; }
    __device__ __forceinline__ void store(const Unit& u, int r, int c, f32x4 v, const Data& d, const Col&) const {
        const size_t o = (size_t)(u.pm * 256 + r) * D + u.pn * 256 + c;
        f32x4 y; y[0] = bflo(d.hw.x) + bflo(d.pw.x) * sigmoidf_(v[0]); y[1] = bfhi(d.hw.x) + bfhi(d.pw.x) * sigmoidf_(v[1]); y[2] = bflo(d.hw.y) + bflo(d.pw.y) * sigmoidf_(v[2]); y[3] = bfhi(d.hw.y) + bfhi(d.pw.y) * sigmoidf_(v[3]);
        if (BOUT) { u32x2 w; w.x = pk2(y[0], y[1]); w.y = pk2(y[2], y[3]); *(u32x2*)((bf16*)hout + o) = w; } else *(f32x4*)((float*)hout + o) = y; }
    __device__ __forceinline__ void store(const Unit& u, int r, int c, f32x4 v) const { store(u, r, c, v, load(u, r, c), Col{}); } };

template <class Epi, class Sched>
__device__ __forceinline__ void gemm_naive(LAS unsigned char* lds, int tid, const Sched& S, const Epi& E) {
    LAS float* As = (LAS float*)lds;
    LAS float* Bs = (LAS float*)(lds + 4096);
    const int tx = tid & 31, ty = tid >> 5;
    const int lrow = tid >> 1, lk = (tid & 1) * 8;
    Unit u;
    for (int i = 0; S.next(i, u); ++i) {
        const bf16* A0 = (const bf16*)S.aptr(u); const bf16* B0 = (const bf16*)S.bptr(u);
        for (int rc = 0; rc < 4; ++rc) {
            f32x4 lo[4], hi[4];
#pragma unroll
            for (int q = 0; q < 4; ++q) { lo[q] = (f32x4){0.f, 0.f, 0.f, 0.f}; hi[q] = (f32x4){0.f, 0.f, 0.f, 0.f}; }
            for (int k0 = 0; k0 < S.K; k0 += 16) {
                __syncthreads();
                { const u32x4 bv = *(const u32x4*)(B0 + (size_t)lrow * S.ldb + k0 + lk);
                  const float f[8] = {bflo(bv.x), bfhi(bv.x), bflo(bv.y), bfhi(bv.y), bflo(bv.z), bfhi(bv.z), bflo(bv.w), bfhi(bv.w)};
#pragma unroll
                  for (int j = 0; j < 8; ++j) Bs[(lk + j) * 256 + lrow] = f[j]; }
                if (tid < 128) { const u32x4 av = *(const u32x4*)(A0 + (size_t)(rc * 64 + lrow) * S.lda + k0 + lk);
                  const float f[8] = {bflo(av.x), bfhi(av.x), bflo(av.y), bfhi(av.y), bflo(av.z), bfhi(av.z), bflo(av.w), bfhi(av.w)};
#pragma unroll
                  for (int j = 0; j < 8; ++j) As[(lk + j) * 64 + lrow] = f[j]; }
                __syncthreads();
#pragma unroll
                for (int k = 0; k < 16; ++k) {
                    const f32x4 a = *(const LAS f32x4*)(As + k * 64 + 4 * ty), b0 = *(const LAS f32x4*)(Bs + k * 256 + 4 * tx), b1 = *(const LAS f32x4*)(Bs + k * 256 + 128 + 4 * tx);
#pragma unroll
                    for (int q = 0; q < 4; ++q) { lo[q] += b0 * a[q]; hi[q] += b1 * a[q]; }
                }
            }
#pragma unroll
            for (int q = 0; q < 4; ++q) { const int r = rc * 64 + 4 * ty + q;
                if constexpr (Epi::DUAL) E.store2(u, r, 4 * tx, lo[q], hi[q]);
                else { E.store(u, r, 4 * tx, lo[q]); E.store(u, r, 128 + 4 * tx, hi[q]); } }
        }
    }
    __syncthreads();
}

namespace pg8 {
constexpr int BK = 64, HALF = 128, HTB = HALF * BK * 2;
__device__ __forceinline__ int lds_byte(int r, int c) { const int st = (r >> 4) * 2 + (c >> 5), rr = r & 15, cc = c & 31, ob = rr * 64 + cc * 2; return st * 1024 + (ob ^ (((ob >> 9) & 1) << 5)); }
__device__ __forceinline__ void stage_rc(int b, int& R, int& C) { const int st = b / 1024, sb = b % 1024, swz = sb ^ (((sb >> 9) & 1) << 5); R = (st >> 1) * 16 + swz / 64; C = (st & 1) * 32 + (swz % 64) / 2; }
template <class Epi, class Sched, bool FP8 = false>
__device__ __forceinline__ void gemm_phase(LAS unsigned char* lds, int tid, const Sched& S, const Epi& E) {
    const int wid = __builtin_amdgcn_readfirstlane(tid >> 6), lane = tid & 63, wr = wid >> 2, wc = wid & 3, fr = lane & 15, fq = lane >> 4;
    const int nt = S.K / BK;
    unsigned voffA[2], voffB[2];
#pragma unroll
    for (int i = 0; i < 2; ++i) { int R, Cc; stage_rc(tid * 16 + i * 8192, R, Cc); const int rho = R & 31, Rb = (R & ~31) + 8 * ((rho & 15) >> 2) + 4 * (rho >> 4) + (rho & 3);
        voffA[i] = (unsigned)(R * S.lda + Cc) * 2u; voffB[i] = (unsigned)(Rb * S.ldb + Cc) * 2u; }
    const size_t kstep = (size_t)(BK * 2);
    const size_t hstepA = (size_t)HALF * S.lda * 2, hstepB = (size_t)HALF * S.ldb * 2;
    const unsigned ldsw = (unsigned)wid * 1024u;
    const int aoff = lds_byte(wr * 64 + fr, fq * 8), boff = lds_byte(wc * 32 + fr, fq * 8);
#define PG8_SA(b, h) (((b) * 2 + (h)) * HTB)
#define PG8_SB(b, h) ((4 + (b) * 2 + (h)) * HTB)
#define PG8_STAGE(bufoff, gbase, voff) do { _Pragma("unroll") for (int _i = 0; _i < 2; ++_i) \
        __builtin_amdgcn_global_load_lds((const unsigned*)((const char*)(gbase) + (voff)[_i]), (LAS unsigned*)(lds + (bufoff) + ldsw + _i * 8192), 16, 0, 0); } while (0)
#define PG8_LDA(dst, b, h) do { _Pragma("unroll") for (int m = 0; m < 4; ++m) _Pragma("unroll") for (int k = 0; k < 2; ++k) dst[m][k] = *(const LAS bf16x8*)(lds + PG8_SA(b, h) + aoff + m * 2048 + k * 1024); } while (0)
#define PG8_LDB(dst, b, h) do { _Pragma("unroll") for (int n = 0; n < 2; ++n) _Pragma("unroll") for (int k = 0; k < 2; ++k) dst[n][k] = *(const LAS bf16x8*)(lds + PG8_SB(b, h) + boff + n * 2048 + k * 1024); } while (0)
#define PG8_MMA(ai, bj, At, Bt) do { __builtin_amdgcn_s_setprio(1); _Pragma("unroll") for (int m = 0; m < 4; ++m) _Pragma("unroll") for (int n = 0; n < 2; ++n) { \
        if constexpr (FP8) { typedef int v8i_ __attribute__((ext_vector_type(8))); typedef int v4i_ __attribute__((ext_vector_type(4))); \
            const v4i_ b0_ = __builtin_bit_cast(v4i_, Bt[n][0]), b1_ = __builtin_bit_cast(v4i_, Bt[n][1]), a0_ = __builtin_bit_cast(v4i_, At[m][0]), a1_ = __builtin_bit_cast(v4i_, At[m][1]); \
            const v8i_ bb_ = {b0_[0], b0_[1], b0_[2], b0_[3], b1_[0], b1_[1], b1_[2], b1_[3]}, aa_ = {a0_[0], a0_[1], a0_[2], a0_[3], a1_[0], a1_[1], a1_[2], a1_[3]}; \
            asm volatile("v_mfma_scale_f32_16x16x128_f8f6f4 %0, %1, %2, %0, %3, %3 op_sel_hi:[0,0,0]" : "+v"(acc[ai][bj][m][n]) : "v"(bb_), "v"(aa_), "v"(f8scale)); } \
        else { _Pragma("unroll") for (int k = 0; k < 2; ++k) acc[ai][bj][m][n] = __builtin_amdgcn_mfma_f32_16x16x32_bf16(Bt[n][k], At[m][k], acc[ai][bj][m][n], 0, 0, 0); } } \
        __builtin_amdgcn_s_setprio(0); } while (0)
#define PG8_WAIT_V(n) asm volatile("s_waitcnt vmcnt(" #n ")" ::: "memory")
#define PG8_WAIT_L(n) asm volatile("s_waitcnt lgkmcnt(" #n ")" ::: "memory")
#define PG8_BAR __builtin_amdgcn_s_barrier()
#define PG8_SCHED __builtin_amdgcn_sched_barrier(0)
    Unit cur, nxt; int ui = 0;
    if (!S.next(0, cur)) return;
    f32x4 acc[2][2][4][2];
#pragma unroll
    for (int a = 0; a < 2; ++a)
#pragma unroll
        for (int b = 0; b < 2; ++b)
#pragma unroll
            for (int m = 0; m < 4; ++m)
#pragma unroll
                for (int n = 0; n < 2; ++n) acc[a][b][m][n] = (f32x4){0.f, 0.f, 0.f, 0.f};
    bf16x8 At[4][2], B0[2][2], B1[2][2];
    const int f8scale = 0x7f7f7f7f; (void)f8scale;
    const char* cA = S.aptr(cur); const char* cB = S.bptr(cur);
    PG8_STAGE(PG8_SB(0, 0), cB, voffB); PG8_STAGE(PG8_SB(0, 1), cB + hstepB, voffB); PG8_STAGE(PG8_SA(0, 0), cA, voffA); PG8_STAGE(PG8_SA(0, 1), cA + hstepA, voffA);
    if (wr == 1) PG8_BAR;
    PG8_WAIT_V(2); PG8_BAR;
    PG8_STAGE(PG8_SB(1, 0), cB + kstep, voffB); PG8_STAGE(PG8_SA(1, 0), cA + kstep, voffA); PG8_STAGE(PG8_SB(1, 1), cB + hstepB + kstep, voffB);
    PG8_WAIT_V(6); PG8_BAR;
    for (;;) {
        const bool has_next = S.next(ui + 1, nxt);
        const char* nA = has_next ? S.aptr(nxt) : cA; const char* nB = has_next ? S.bptr(nxt) : cB;
        for (int t = 0; t < nt; t += 2) {
            const bool last = (t == nt - 2);
            const char* a1 = cA + (size_t)(t + 1) * kstep;
            const char* a2 = last ? nA : cA + (size_t)(t + 2) * kstep; const char* b2 = last ? nB : cB + (size_t)(t + 2) * kstep;
            const char* a3 = a2 + kstep; const char* b3 = b2 + kstep;
            PG8_LDB(B0, 0, 0); PG8_LDB(B1, 0, 1); PG8_SCHED; PG8_LDA(At, 0, 0); PG8_STAGE(PG8_SA(1, 1), a1 + hstepA, voffA);
            PG8_WAIT_V(8); PG8_WAIT_L(0); PG8_BAR; PG8_MMA(0, 0, At, B0); PG8_MMA(0, 1, At, B1); PG8_BAR; PG8_SCHED;
            PG8_LDA(At, 0, 1); PG8_STAGE(PG8_SB(0, 0), b2, voffB); PG8_STAGE(PG8_SB(0, 1), b2 + hstepB, voffB); PG8_STAGE(PG8_SA(0, 0), a2, voffA);
            PG8_WAIT_V(8); PG8_WAIT_L(0); PG8_BAR; PG8_MMA(1, 0, At, B0); PG8_MMA(1, 1, At, B1); PG8_BAR; PG8_SCHED;
            PG8_LDB(B0, 1, 0); PG8_LDB(B1, 1, 1); PG8_SCHED; PG8_LDA(At, 1, 0); PG8_STAGE(PG8_SA(0, 1), a2 + hstepA, voffA);
            PG8_WAIT_V(8); PG8_WAIT_L(0); PG8_BAR; PG8_MMA(0, 0, At, B0); PG8_MMA(0, 1, At, B1); PG8_BAR; PG8_SCHED;
            PG8_LDA(At, 1, 1); PG8_STAGE(PG8_SB(1, 0), b3, voffB); PG8_STAGE(PG8_SB(1, 1), b3 + hstepB, voffB); PG8_STAGE(PG8_SA(1, 0), a3, voffA);
            PG8_WAIT_V(8); PG8_WAIT_L(0); PG8_BAR; PG8_MMA(1, 0, At, B0); PG8_MMA(1, 1, At, B1); PG8_BAR; PG8_SCHED;
        }
        if (wr == 0) PG8_BAR;
        if constexpr (FP8) asm volatile("s_nop 15\n\ts_nop 15" ::: "memory");
        Unit eu; eu.pm = __builtin_amdgcn_readfirstlane(cur.pm); eu.pn = __builtin_amdgcn_readfirstlane(cur.pn); eu.g = __builtin_amdgcn_readfirstlane(cur.g); eu.k = __builtin_amdgcn_readfirstlane(cur.k); asm volatile("" : "+s"(eu.pm), "+s"(eu.pn), "+s"(eu.g), "+s"(eu.k));
        if constexpr (Epi::PRELOAD) {
            typename Epi::Col cv[2];
#pragma unroll
            for (int n = 0; n < 2; ++n) cv[n] = E.cload(eu, wc * 32 + 8 * fq + 4 * n);
            constexpr int NB = Epi::DUAL ? 2 : 4;
            typename Epi::Data dd[2][8];
#define PG8_EPI_LOAD(b_, slot_) do { _Pragma("unroll") for (int j_ = 0; j_ < 8; ++j_) { int ai_, m_, bj_, n_; \
                if constexpr (Epi::DUAL) { ai_ = (b_); m_ = j_ >> 1; bj_ = 0; n_ = j_ & 1; } else { ai_ = (b_) >> 1; m_ = 2 * ((b_) & 1) + (j_ >> 2); bj_ = (j_ >> 1) & 1; n_ = j_ & 1; } \
                dd[slot_][j_] = E.load(eu, ai_ * 128 + wr * 64 + m_ * 16 + fr, bj_ * 128 + wc * 32 + 8 * fq + 4 * n_); } } while (0)
            PG8_EPI_LOAD(0, 0);
#pragma unroll
            for (int b = 0; b < NB; ++b) {
                if (b + 1 < NB) PG8_EPI_LOAD(b + 1, (b + 1) & 1);
#pragma unroll
                for (int j = 0; j < 8; ++j) { int ai, m, bj, n;
                    if constexpr (Epi::DUAL) { ai = b; m = j >> 1; bj = 0; n = j & 1; } else { ai = b >> 1; m = 2 * (b & 1) + (j >> 2); bj = (j >> 1) & 1; n = j & 1; }
                    const int r = ai * 128 + wr * 64 + m * 16 + fr, c = wc * 32 + 8 * fq + 4 * n;
                    if constexpr (Epi::DUAL) E.store2(eu, r, c, acc[ai][0][m][n], acc[ai][1][m][n], dd[b & 1][j], cv[n]);
                    else E.store(eu, r, bj * 128 + c, acc[ai][bj][m][n], dd[b & 1][j], cv[n]); }
            }
#undef PG8_EPI_LOAD
        } else {
#pragma unroll
        for (int ai = 0; ai < 2; ++ai)
#pragma unroll
            for (int m = 0; m < 4; ++m) { const int r = ai * 128 + wr * 64 + m * 16 + fr;
                if constexpr (Epi::DUAL) {
#pragma unroll
                    for (int n = 0; n < 2; ++n) E.store2(eu, r, wc * 32 + 8 * fq + 4 * n, acc[ai][0][m][n], acc[ai][1][m][n]);
                } else {
#pragma unroll
                    for (int bj = 0; bj < 2; ++bj)
#pragma unroll
                        for (int n = 0; n < 2; ++n) E.store(eu, r, bj * 128 + wc * 32 + 8 * fq + 4 * n, acc[ai][bj][m][n]); } }
        }
        if (!has_next) break;
#pragma unroll
        for (int a = 0; a < 2; ++a)
#pragma unroll
            for (int b = 0; b < 2; ++b)
#pragma unroll
                for (int m = 0; m < 4; ++m)
#pragma unroll
                    for (int n = 0; n < 2; ++n) acc[a][b][m][n] = (f32x4){0.f, 0.f, 0.f, 0.f};
        cur = nxt; cA = nA; cB = nB; ++ui;
        if (wr == 1) PG8_BAR;
    }
    PG8_WAIT_V(0);
    PG8_BAR;
#undef PG8_SA
#undef PG8_SB
#undef PG8_STAGE
#undef PG8_LDA
#undef PG8_LDB
#undef PG8_MMA
#undef PG8_WAIT_V
#undef PG8_WAIT_L
#undef PG8_BAR
#undef PG8_SCHED
}
}

template <class Epi, class Sched>
__device__ __forceinline__ void gemm_run_fp8(Ctx& C, const Sched& S, const Epi& E) { pg8::gemm_phase<Epi, Sched, true>(C.lds, C.tid, S, E); }
template <class Epi, class Sched>
__device__ __forceinline__ void gemm_run(Ctx& C, const Sched& S, const Epi& E) {
#if FAST_GEMM
    pg8::gemm_phase<Epi, Sched>(C.lds, C.tid, S, E);
#else
    gemm_naive<Epi, Sched>(C.lds, C.tid, S, E);
#endif
}

__device__ __forceinline__ int win_col(int n) {
    if (n < 6144) return n;
    if (n < 6912) return 6224 + (n - 6144);
    if (n < 7424) return 6992 + (n - 6912);
    if (n < 7488) return 6144 + (n - 7424);
    if (n < 7552) return 7504 + (n - 7488);
    if (n < 7568) return 6208 + (n - 7552);
    if (n < 7680) return -1;
    return 7568 + (n - 7680);
}
struct RsPlain { const float* s; __device__ __forceinline__ const float* operator()(int n) const { return s + n; } };
struct RsWin { const float* s; __device__ __forceinline__ const float* operator()(int n) const { const int c = win_col(n); return c < 0 ? nullptr : s + c; } };
struct RsGU { const float* g; ptrdiff_t du; __device__ __forceinline__ const float* operator()(int n) const { const int tile = n >> 8, r = n & 255; return g + (r < 128 ? (ptrdiff_t)0 : du) + tile * 128 + (r & 127); } };
template <class RS>
__device__ __forceinline__ void conv_job(Ctx& C, bf16* dst, int nrows, int K, int srcN, const RS& rs) {
#if FAST_CONV
    LAS unsigned char* tile = C.lds;
    const int nkb = K / 64, nitems = (nrows / 256) * nkb, w = C.wave, L = C.lane, tid = C.tid;
    f32x4 v[8], vn[8]; float zf = 1.f, zfn = 1.f;
#define CJ_LOAD(it_, dst_, z_) do { const int nb_ = (it_) / nkb, kb_ = (it_) % nkb; const float* sp_ = rs(nb_ * 256 + 4 * L); z_ = sp_ ? 1.f : 0.f; sp_ = sp_ ? sp_ : rs(0); \
        _Pragma("unroll") for (int j = 0; j < 8; ++j) dst_[j] = __builtin_nontemporal_load((const f32x4*)(sp_ + (size_t)(kb_ * 64 + 8 * w + j) * srcN)); } while (0)
#define CJ_PROC(it_, src_, z_) do { const int nb_ = (it_) / nkb, kb_ = (it_) % nkb, n0_ = nb_ * 256, k0_ = kb_ * 64; \
        asm volatile("s_waitcnt lgkmcnt(0)" ::: "memory"); __builtin_amdgcn_s_barrier();     \
        _Pragma("unroll") for (int q = 0; q < 4; ++q) { u32x4 o; o.x = pk2(src_[0][q] * z_, src_[1][q] * z_); o.y = pk2(src_[2][q] * z_, src_[3][q] * z_); o.z = pk2(src_[4][q] * z_, src_[5][q] * z_); o.w = pk2(src_[6][q] * z_, src_[7][q] * z_); \
            *(LAS u32x4*)(tile + (4 * L + q) * 144 + w * 16) = o; } \
        asm volatile("s_waitcnt lgkmcnt(0)" ::: "memory"); __builtin_amdgcn_s_barrier(); \
        _Pragma("unroll") for (int i = 0; i < 4; ++i) { const int idx = tid + 512 * i, n = idx >> 3, ch = idx & 7; const u32x4 o = *(const LAS u32x4*)(tile + n * 144 + ch * 16); *(u32x4*)(dst + (size_t)(n0_ + n) * K + k0_ + ch * 8) = o; } } while (0)
    int it = C.bid;
    if (it < nitems) {
        CJ_LOAD(it, v, zf);
        for (;;) {
            { const int nx = it + C.G, nc = nx < nitems ? nx : nitems - 1; CJ_LOAD(nc, vn, zfn); CJ_PROC(it, v, zf); it = nx; if (it >= nitems) break; }
            { const int nx = it + C.G, nc = nx < nitems ? nx : nitems - 1; CJ_LOAD(nc, v, zf); CJ_PROC(it, vn, zfn); it = nx; if (it >= nitems) break; }
        }
    }
#undef CJ_LOAD
#undef CJ_PROC
    __syncthreads();
#else
    const size_t tot = (size_t)nrows * K, gsz = (size_t)C.G * 512;
    for (size_t i = (size_t)C.bid * 512 + C.tid; i < tot; i += gsz) { const int k = (int)(i / nrows), n = (int)(i % nrows); const float* sp = rs(n);
        dst[(size_t)n * K + k] = sp ? f2bf(sp[(size_t)k * srcN]) : (bf16)0; }
#endif
}

template <class RS>
__device__ __forceinline__ void conv_job_fp8(Ctx& C, unsigned char* dst, int nrows, int K, int srcN, const RS& rs, float scale) {
    LAS unsigned char* tile = C.lds;
    const int nkb = K / 128, nitems = (nrows / 256) * nkb, w = C.wave, L = C.lane, tid = C.tid;
    f32x4 v[16], vn[16];
#define CJ_LOAD8(it_, dst_) do { const int nb_ = (it_) / nkb, kb_ = (it_) % nkb; const float* sp_ = rs(nb_ * 256 + 4 * L); _Pragma("unroll") for (int j = 0; j < 16; ++j) \
        dst_[j] = __builtin_nontemporal_load((const f32x4*)(sp_ + (size_t)(kb_ * 128 + 16 * w + j) * srcN)); } while (0)
#define CJ_PROC8(it_, src_) do { const int nb_ = (it_) / nkb, kb_ = (it_) % nkb, n0_ = nb_ * 256, k0_ = kb_ * 128; \
        asm volatile("s_waitcnt lgkmcnt(0)" ::: "memory"); __builtin_amdgcn_s_barrier(); \
        _Pragma("unroll") for (int q = 0; q < 4; ++q) { u32x4 o; o.x = pk4_fp8(src_[0][q] * scale, src_[1][q] * scale, src_[2][q] * scale, src_[3][q] * scale); o.y = pk4_fp8(src_[4][q] * scale, src_[5][q] * scale, src_[6][q] * scale, src_[7][q] * scale); \
            o.z = pk4_fp8(src_[8][q] * scale, src_[9][q] * scale, src_[10][q] * scale, src_[11][q] * scale); o.w = pk4_fp8(src_[12][q] * scale, src_[13][q] * scale, src_[14][q] * scale, src_[15][q] * scale); \
            *(LAS u32x4*)(tile + (4 * L + q) * 144 + w * 16) = o; } \
        asm volatile("s_waitcnt lgkmcnt(0)" ::: "memory"); __builtin_amdgcn_s_barrier(); \
        _Pragma("unroll") for (int i = 0; i < 4; ++i) { const int idx = tid + 512 * i, n = idx >> 3, ch = idx & 7; const u32x4 o = *(const LAS u32x4*)(tile + n * 144 + ch * 16); *(u32x4*)(dst + (size_t)(n0_ + n) * K + k0_ + ch * 16) = o; } } while (0)
    int it = C.bid;
    if (it < nitems) {
        CJ_LOAD8(it, v);
        for (;;) {
            { const int nx = it + C.G, nc = nx < nitems ? nx : nitems - 1; CJ_LOAD8(nc, vn); CJ_PROC8(it, v); it = nx; if (it >= nitems) break; }
            { const int nx = it + C.G, nc = nx < nitems ? nx : nitems - 1; CJ_LOAD8(nc, v); CJ_PROC8(it, vn); it = nx; if (it >= nitems) break; }
        }
    }
#undef CJ_LOAD8
#undef CJ_PROC8
    __syncthreads();
}

template <bool ROUTER, int OUT8 = 0, bool SRC16 = true>
__device__ __forceinline__ void rmsnorm_rows(Ctx& C, const void* src, const float* gain, bf16* dst, const float* router, int* toke, float* tokg, unsigned char* dst8 = nullptr) {
    const int gw = C.bid * 8 + C.wave, NGW = C.G * 8, lane = C.lane;
    for (int m = gw; m < M; m += NGW) {
        f32x4 v[8]; float ss = 0.f;
#pragma unroll
        for (int j = 0; j < 8; ++j) { if (SRC16) { const u32x2 w = ((const u32x2*)((const bf16*)src + (size_t)m * D))[lane + 64 * j]; v[j] = (f32x4){bflo(w.x), bfhi(w.x), bflo(w.y), bfhi(w.y)}; } else v[j] = ((const f32x4*)((const float*)src + (size_t)m * D))[lane + 64 * j];
            ss += (v[j][0] * v[j][0] + v[j][1] * v[j][1]) + (v[j][2] * v[j][2] + v[j][3] * v[j][3]); }
        const float rstd = 1.0f / sqrtf(wave_sum(ss) * (1.0f / D) + EPS);
        float lg[8];
        if (ROUTER) {
#pragma unroll
            for (int e = 0; e < 8; ++e) lg[e] = 0.f; }
#pragma unroll
        for (int j = 0; j < 8; ++j) { const f32x4 g4 = ((const f32x4*)gain)[lane + 64 * j]; const f32x4 y = v[j] * rstd * g4;
            if (OUT8 == 1) { *(unsigned*)((unsigned char*)dst + (size_t)m * D + 4 * (lane + 64 * j)) = pk4_fp8(y[0] * F8_XSCALE, y[1] * F8_XSCALE, y[2] * F8_XSCALE, y[3] * F8_XSCALE); }
            else { u32x2 w; w.x = pk2(y[0], y[1]); w.y = pk2(y[2], y[3]); *(u32x2*)(dst + (size_t)m * D + 4 * (lane + 64 * j)) = w;
                if (OUT8 == 2) *(unsigned*)(dst8 + (size_t)m * D + 4 * (lane + 64 * j)) = pk4_fp8(y[0] * F8_XSCALE, y[1] * F8_XSCALE, y[2] * F8_XSCALE, y[3] * F8_XSCALE); }
            if (ROUTER) {
#pragma unroll
                for (int q = 0; q < 4; ++q) { const f32x4* rp = (const f32x4*)(router + (size_t)(4 * (lane + 64 * j) + q) * 8); const f32x4 r0 = rp[0], r1 = rp[1];
                    lg[0] += y[q] * r0[0]; lg[1] += y[q] * r0[1]; lg[2] += y[q] * r0[2]; lg[3] += y[q] * r0[3]; lg[4] += y[q] * r1[0]; lg[5] += y[q] * r1[1]; lg[6] += y[q] * r1[2]; lg[7] += y[q] * r1[3]; } } }
        if (ROUTER) {
#pragma unroll
            for (int e = 0; e < 8; ++e) lg[e] = wave_sum(lg[e]);
            int e0 = 0; float v0 = lg[0];
#pragma unroll
            for (int e = 1; e < 8; ++e) if (lg[e] > v0) { v0 = lg[e]; e0 = e; }
            int e1 = -1; float v1 = -INFINITY;
#pragma unroll
            for (int e = 0; e < 8; ++e) if (e != e0 && lg[e] > v1) { v1 = lg[e]; e1 = e; }
            const float g1 = 1.0f / (1.0f + __expf(v0 - v1)), g0 = 1.0f - g1;
            if (lane == 0) { toke[2 * m] = e0; toke[2 * m + 1] = e1; tokg[2 * m] = g0; tokg[2 * m + 1] = g1; }
        }
    }
}

__device__ __forceinline__ void rope_sc(float posf, int i, int d, float& sn, float& cs) {
    const float invf = exp2f(-(float)i * (2.0f / (float)d) * LOG2_THETA); const float rev = posf * invf * INV_2PI; const float fr = rev - floorf(rev);
    sn = __builtin_amdgcn_sinf(fr); cs = __builtin_amdgcn_cosf(fr);
}
__device__ __forceinline__ void postproj_tokens(Ctx& C, const bf16* proj, const int* pos, const float* convw, const float* convb, const float* gq, const float* gk, const float* qan, const float* kvan,
                                                bf16* xc, bf16* qs, bf16* ks, bf16* qi, bf16* ki, bf16* cqn, bf16* ckvn) {
    const int gw = C.bid * 8 + C.wave, NGW = C.G * 8, lane = C.lane;
    const float QSCALE = 0.08838834764831845f;
    for (int m = gw; m < M; m += NGW) {
        const int t = m & (T - 1); const bf16* pr = proj + (size_t)m * PROJ_N; const float posf = (float)pos[m];
#pragma unroll
        for (int half = 0; half < 2; ++half) { const int c0 = half * 512 + lane * 8; float a[8];
#pragma unroll
            for (int i = 0; i < 8; ++i) a[i] = convb[c0 + i];
#pragma unroll
            for (int j = 0; j < 4; ++j) { if (t - 3 + j >= 0) { const u32x4 xv = *(const u32x4*)(pr - (ptrdiff_t)(3 - j) * PROJ_N + PX_LRUX + c0); const float* w = convw + j * 1024 + c0;
                a[0] += w[0] * bflo(xv.x); a[1] += w[1] * bfhi(xv.x); a[2] += w[2] * bflo(xv.y); a[3] += w[3] * bfhi(xv.y); a[4] += w[4] * bflo(xv.z); a[5] += w[5] * bfhi(xv.z); a[6] += w[6] * bflo(xv.w); a[7] += w[7] * bfhi(xv.w); } }
            u32x4 o; o.x = pk2(a[0], a[1]); o.y = pk2(a[2], a[3]); o.z = pk2(a[4], a[5]); o.w = pk2(a[6], a[7]); *(u32x4*)(xc + (size_t)m * 1024 + c0) = o; }
        { float sn, cs; rope_sc(posf, lane, 128, sn, cs);
#pragma unroll
          for (int h = 0; h < 8; ++h) {
#pragma unroll
            for (int which = 0; which < 2; ++which) { const int base = (which ? PX_AK : PX_AQ) + h * 128; const float* gg = which ? gk : gq;
                const float x1 = bf2f(pr[base + lane]), x2 = bf2f(pr[base + 64 + lane]); const float rstd = 1.0f / sqrtf(wave_sum(x1 * x1 + x2 * x2) * (1.0f / 128.0f) + EPS);
                const float y1 = x1 * rstd * gg[lane], y2 = x2 * rstd * gg[64 + lane]; const float sc = which ? 1.0f : QSCALE;
                bf16* o = (which ? ks : qs) + (size_t)m * 1024 + h * 128; o[lane] = f2bf((y1 * cs - y2 * sn) * sc); o[64 + lane] = f2bf((y2 * cs + y1 * sn) * sc); } } }
        { const int i = lane & 31; float sn, cs; rope_sc(posf, i, 64, sn, cs);
#pragma unroll
          for (int hh = 0; hh < 8; ++hh) { const int head = 2 * hh + (lane >> 5), base = PX_IQ + head * 64; const float x1 = bf2f(pr[base + i]), x2 = bf2f(pr[base + 32 + i]);
              bf16* o = qi + (size_t)m * 1024 + head * 64; o[i] = f2bf(x1 * cs - x2 * sn); o[32 + i] = f2bf(x2 * cs + x1 * sn); }
          if (lane < 32) { const float x1 = bf2f(pr[PX_IK + i]), x2 = bf2f(pr[PX_IK + 32 + i]); bf16* o = ki + (size_t)m * 64; o[i] = f2bf(x1 * cs - x2 * sn); o[32 + i] = f2bf(x2 * cs + x1 * sn); } }
        { float v[12]; float ss = 0.f;
#pragma unroll
          for (int j = 0; j < 12; ++j) { v[j] = bf2f(pr[PX_CQ + lane + 64 * j]); ss += v[j] * v[j]; }
          const float rstd = 1.0f / sqrtf(wave_sum(ss) * (1.0f / 768.0f) + EPS);
#pragma unroll
          for (int j = 0; j < 12; ++j) cqn[(size_t)m * 768 + lane + 64 * j] = f2bf(v[j] * rstd * qan[lane + 64 * j]); }
        { float v[8]; float ss = 0.f;
#pragma unroll
          for (int j = 0; j < 8; ++j) { v[j] = bf2f(pr[PX_CKV + lane + 64 * j]); ss += v[j] * v[j]; }
          const float rstd = 1.0f / sqrtf(wave_sum(ss) * (1.0f / 512.0f) + EPS);
#pragma unroll
          for (int j = 0; j < 8; ++j) ckvn[(size_t)m * 512 + lane + 64 * j] = f2bf(v[j] * rstd * kvan[lane + 64 * j]); }
    }
}
__device__ __forceinline__ void transpose_v(Ctx& C, const bf16* src, int pitch, int col0, int hstride, bf16* dst) {
    LAS bf16* tile = (LAS bf16*)C.lds;
    for (int u = C.bid; u < NB * 8 * 32; u += C.G) {
        const int tc = u & 31, h = (u >> 5) & 7, b = u >> 8;
        __syncthreads();
#pragma unroll
        for (int i = 0; i < 2; ++i) { const int idx = C.tid + i * 512, tl = idx >> 4, dc = idx & 15;
            const u32x4 v = *(const u32x4*)(src + (size_t)(b * T + tc * 64 + tl) * pitch + col0 + h * hstride + dc * 8); *(LAS u32x4*)(tile + tl * 136 + dc * 8) = v; }
        __syncthreads();
#pragma unroll
        for (int i = 0; i < 2; ++i) { const int idx = C.tid + i * 512, d = idx >> 3, t8 = idx & 7; const LAS bf16* s = tile + (t8 * 8) * 136 + d;
            u32x4 o; o.x = (unsigned)s[0] | ((unsigned)s[136] << 16); o.y = (unsigned)s[2 * 136] | ((unsigned)s[3 * 136] << 16); o.z = (unsigned)s[4 * 136] | ((unsigned)s[5 * 136] << 16); o.w = (unsigned)s[6 * 136] | ((unsigned)s[7 * 136] << 16);
#ifdef TV_SHORT_STORES
            { bf16* dp = dst + ((size_t)((b * 8 + h) * 128 + d)) * T + tc * 64 + t8 * 8; dp[0] = (bf16)(o.x & 0xffff); dp[1] = (bf16)(o.x >> 16); dp[2] = (bf16)(o.y & 0xffff); dp[3] = (bf16)(o.y >> 16); dp[4] = (bf16)(o.z & 0xffff); dp[5] = (bf16)(o.z >> 16); dp[6] = (bf16)(o.w & 0xffff); dp[7] = (bf16)(o.w >> 16); }
#else
            *(u32x4*)(dst + ((size_t)((b * 8 + h) * 128 + d)) * T + tc * 64 + t8 * 8) = o;
#endif
            }
    }
    __syncthreads();
}

__device__ __forceinline__ void topk_select(const LAS float* scw, int t, u64* maskrow, int lane) {
    u64 myword = 0;
    if (t + 1 <= 256) { int nv = t + 1 - 64 * lane; nv = nv < 0 ? 0 : (nv > 64 ? 64 : nv); myword = nv >= 64 ? ~0ull : ((1ull << nv) - 1ull); }
    else {
        unsigned A[32];
#pragma unroll
        for (int jj = 0; jj < 32; ++jj) { const unsigned bits = __builtin_bit_cast(unsigned, scw[jj * 64 + lane]); const unsigned uu = (bits & 0x80000000u) ? ~bits : (bits | 0x80000000u); A[31 - jj] = (jj * 64 + lane <= t) ? uu : 0u; }
        { unsigned msk = 0x0000FFFFu;
#pragma unroll
          for (int j = 16; j != 0; j >>= 1) {
#pragma unroll
              for (int k = 0; k < 32; k = (k + j + 1) & ~j) { const unsigned tt = (A[k] ^ (A[k + j] >> j)) & msk; A[k] ^= tt; A[k + j] ^= tt << j; }
              msk ^= msk << (j >> 1); } }
        unsigned gt = 0u, cand = 0xFFFFFFFFu;
#pragma unroll
        for (int p = 0; p < 32; ++p) { const unsigned x = cand & A[p], y = gt | x; const int cnt = wave_sum_i(__popc(y));
            if (cnt >= 256) { cand = x; if (cnt == 256) break; } else { gt = y; cand &= ~A[p]; } }
        int need = 256 - wave_sum_i(__popc(gt));
#pragma unroll
        for (int jj = 0; jj < 32; ++jj) { u64 g = __ballot((gt >> jj) & 1u); const u64 e = __ballot((cand >> jj) & 1u);
            if (need > 0 && e != 0ull) { const int c = __popcll(e);
                if (c <= need) { g |= e; need -= c; }
                else { u64 keep = 0ull, ee = e; for (int q = 0; q < need; ++q) { keep |= ee & (0ull - ee); ee &= ee - 1ull; } g |= keep; need = 0; } }
            if (lane == jj) myword = g; }
    }
    if (lane < 32) maskrow[lane] = myword;
}
__device__ __forceinline__ void indexer_naive(Ctx& C, const bf16* proj, const bf16* qi, const bf16* ki, u64* sel) {
    LAS float* qf = (LAS float*)(C.lds + C.wave * 16384); LAS float* scw = qf + 1024;
    const int gw = C.bid * 8 + C.wave, NGW = C.G * 8, lane = C.lane;
    for (int m = gw; m < M; m += NGW) {
        const int b = m >> 11, t = m & (T - 1);
        if (t + 1 > 256) {
            { const u32x4 a = *(const u32x4*)(qi + (size_t)m * 1024 + lane * 16), c = *(const u32x4*)(qi + (size_t)m * 1024 + lane * 16 + 8); LAS float* o = qf + lane * 16;
              o[0] = bflo(a.x); o[1] = bfhi(a.x); o[2] = bflo(a.y); o[3] = bfhi(a.y); o[4] = bflo(a.z); o[5] = bfhi(a.z); o[6] = bflo(a.w); o[7] = bfhi(a.w);
              o[8] = bflo(c.x); o[9] = bfhi(c.x); o[10] = bflo(c.y); o[11] = bfhi(c.y); o[12] = bflo(c.z); o[13] = bfhi(c.z); o[14] = bflo(c.w); o[15] = bfhi(c.w); }
            const float iwv = lane < 16 ? bf2f(proj[(size_t)m * PROJ_N + PX_IW + lane]) : 0.f;
            asm volatile("s_waitcnt lgkmcnt(0)" ::: "memory");
#pragma nounroll
            for (int jj = 0; jj < 32; ++jj) {
                if (jj * 64 > t) { scw[jj * 64 + lane] = -INFINITY; continue; }
                const int key = jj * 64 + lane; const u32x4* kp = (const u32x4*)(ki + (size_t)(b * T + key) * 64); float kf[64];
#pragma unroll
                for (int c8 = 0; c8 < 8; ++c8) { const u32x4 kv = kp[c8]; kf[c8 * 8 + 0] = bflo(kv.x); kf[c8 * 8 + 1] = bfhi(kv.x); kf[c8 * 8 + 2] = bflo(kv.y); kf[c8 * 8 + 3] = bfhi(kv.y); kf[c8 * 8 + 4] = bflo(kv.z); kf[c8 * 8 + 5] = bfhi(kv.z); kf[c8 * 8 + 6] = bflo(kv.w); kf[c8 * 8 + 7] = bfhi(kv.w); }
                float s = 0.f;
#pragma nounroll
                for (int h = 0; h < 16; ++h) { const float wh = rd_lane(iwv, h); float d = 0.f;
#pragma unroll
                    for (int i4 = 0; i4 < 16; ++i4) { const f32x4 q4 = *(const LAS f32x4*)(qf + h * 64 + i4 * 4); d += q4[0] * kf[i4 * 4] + q4[1] * kf[i4 * 4 + 1] + q4[2] * kf[i4 * 4 + 2] + q4[3] * kf[i4 * 4 + 3]; }
                    s += wh * fmaxf(d, 0.f); }
                scw[key] = (key <= t) ? s : -INFINITY;
            }
            asm volatile("s_waitcnt lgkmcnt(0)" ::: "memory");
        }
        topk_select(scw, t, sel + (size_t)m * 32, lane);
    }
}

__device__ __forceinline__ void sparse_attn_naive(Ctx& C, const bf16* proj, const bf16* qs, const bf16* ks, const u64* sel, bf16* outb) {
    LAS float* qf = (LAS float*)(C.lds + C.wave * 16384); LAS float* scw = qf + 256;
    const int gw = C.bid * 8 + C.wave, NGW = C.G * 8, lane = C.lane;
    for (int m = gw; m < M; m += NGW) {
        const int b = m >> 11;
        unsigned wlo = 0u, whi = 0u; if (lane < 32) { const u64 w = sel[(size_t)m * 32 + lane]; wlo = (unsigned)w; whi = (unsigned)(w >> 32); }
        for (int h = 0; h < 8; ++h) {
            qf[lane] = bf2f(qs[(size_t)m * 1024 + h * 128 + lane]); qf[64 + lane] = bf2f(qs[(size_t)m * 1024 + h * 128 + 64 + lane]);
            asm volatile("s_waitcnt lgkmcnt(0)" ::: "memory");
            float mx = -INFINITY;
            for (int jj = 0; jj < 32; ++jj) { const u64 w = ((u64)rd_lane_u(whi, jj) << 32) | (u64)rd_lane_u(wlo, jj); if (w == 0ull) continue;
                float s = -INFINITY;
                if ((w >> lane) & 1ull) { const u32x4* kp = (const u32x4*)(ks + (size_t)(b * T + jj * 64 + lane) * 1024 + h * 128); float d = 0.f;
#pragma unroll
                    for (int c8 = 0; c8 < 16; ++c8) { const u32x4 kv = kp[c8]; const f32x4 q0 = *(const LAS f32x4*)(qf + c8 * 8), q1 = *(const LAS f32x4*)(qf + c8 * 8 + 4);
                        d += q0[0] * bflo(kv.x) + q0[1] * bfhi(kv.x) + q0[2] * bflo(kv.y) + q0[3] * bfhi(kv.y) + q1[0] * bflo(kv.z) + q1[1] * bfhi(kv.z) + q1[2] * bflo(kv.w) + q1[3] * bfhi(kv.w); }
                    s = d; }
                scw[jj * 64 + lane] = s; mx = fmaxf(mx, s); }
            mx = wave_max(mx);
            float sum = 0.f;
            for (int jj = 0; jj < 32; ++jj) { const u64 w = ((u64)rd_lane_u(whi, jj) << 32) | (u64)rd_lane_u(wlo, jj); if (w == 0ull) continue;
                const float s = scw[jj * 64 + lane]; const float p = ((w >> lane) & 1ull) ? __expf(s - mx) : 0.f; scw[jj * 64 + lane] = p; sum += p; }
            sum = wave_sum(sum);
            asm volatile("s_waitcnt lgkmcnt(0)" ::: "memory");
            float a0 = 0.f, a1 = 0.f;
            for (int jj = 0; jj < 32; ++jj) { u64 w = ((u64)rd_lane_u(whi, jj) << 32) | (u64)rd_lane_u(wlo, jj);
                while (w) { const int bit = __builtin_ctzll(w); w &= w - 1ull; const float p = scw[jj * 64 + bit]; const bf16* vp = proj + (size_t)(b * T + jj * 64 + bit) * PROJ_N + PX_AV + h * 128;
                    a0 += p * bf2f(vp[lane]); a1 += p * bf2f(vp[64 + lane]); } }
            const float inv = 1.0f / sum; outb[(size_t)m * 1024 + h * 128 + lane] = f2bf(a0 * inv); outb[(size_t)m * 1024 + h * 128 + 64 + lane] = f2bf(a1 * inv);
        }
    }
}
__device__ __forceinline__ void mla_attn_naive(Ctx& C, const bf16* qm, const bf16* km, const bf16* kvmr, bf16* outc) {
    LAS float* qf = (LAS float*)(C.lds + C.wave * 16384); LAS float* scw = qf + 256;
    const int gw = C.bid * 8 + C.wave, NGW = C.G * 8, lane = C.lane;
    for (int m = gw; m < M; m += NGW) {
        const int b = m >> 11, t = m & (T - 1), njj = (t >> 6) + 1;
        for (int h = 0; h < 8; ++h) {
            qf[lane] = bf2f(qm[(size_t)m * 1536 + h * 192 + lane]); qf[64 + lane] = bf2f(qm[(size_t)m * 1536 + h * 192 + 64 + lane]); qf[128 + lane] = bf2f(qm[(size_t)m * 1536 + h * 192 + 128 + lane]);
            asm volatile("s_waitcnt lgkmcnt(0)" ::: "memory");
            float mx = -INFINITY;
            for (int jj = 0; jj < njj; ++jj) { const int key = jj * 64 + lane; float s = -INFINITY;
                if (key <= t) { const u32x4* kp = (const u32x4*)(km + (size_t)(b * T + key) * 1536 + h * 192); float d = 0.f;
#pragma unroll
                    for (int c8 = 0; c8 < 24; ++c8) { const u32x4 kv = kp[c8]; const f32x4 q0 = *(const LAS f32x4*)(qf + c8 * 8), q1 = *(const LAS f32x4*)(qf + c8 * 8 + 4);
                        d += q0[0] * bflo(kv.x) + q0[1] * bfhi(kv.x) + q0[2] * bflo(kv.y) + q0[3] * bfhi(kv.y) + q1[0] * bflo(kv.z) + q1[1] * bfhi(kv.z) + q1[2] * bflo(kv.w) + q1[3] * bfhi(kv.w); }
                    s = d; }
                scw[key] = s; mx = fmaxf(mx, s); }
            mx = wave_max(mx);
            float sum = 0.f;
            for (int jj = 0; jj < njj; ++jj) { const int key = jj * 64 + lane; const float s = scw[key]; const float p = (key <= t) ? __expf(s - mx) : 0.f; scw[key] = p; sum += p; }
            sum = wave_sum(sum);
            asm volatile("s_waitcnt lgkmcnt(0)" ::: "memory");
            float a0 = 0.f, a1 = 0.f;
            for (int key = 0; key <= t; ++key) { const float p = scw[key]; const bf16* vp = kvmr + (size_t)(b * T + key) * 2048 + h * 256 + 128; a0 += p * bf2f(vp[lane]); a1 += p * bf2f(vp[64 + lane]); }
            const float inv = 1.0f / sum; outc[(size_t)m * 1024 + h * 128 + lane] = f2bf(a0 * inv); outc[(size_t)m * 1024 + h * 128 + 64 + lane] = f2bf(a1 * inv);
        }
    }
}

template <int DQK, bool SPARSE>
__device__ __forceinline__ void attn_mfma(Ctx& C, const bf16* __restrict__ Q, const bf16* __restrict__ K, const bf16* __restrict__ Vt, const u64* __restrict__ sel, bf16* __restrict__ O) {
    constexpr int NC = DQK / 32, NCB = DQK / 64, KTB = NCB * 8192, VTB = 2 * 8192, NP = NCB + 2 + (SPARSE ? 1 : 0);
    constexpr int MOFF = 3 * KTB + 3 * VTB, MSB = 8 * 256;
    static_assert(MOFF + 3 * MSB <= LDS_RING, "attention LDS");
    constexpr float LOG2E = 1.4426950408889634f;
    const int lane = C.lane, wave = C.wave, r = lane & 15, g = lane >> 4;
    LAS unsigned char* const lds = C.lds;
    const unsigned ldsw = (unsigned)(size_t)lds + (unsigned)(wave * 1024);
    const unsigned ldsm = (unsigned)(size_t)lds + (unsigned)(MOFF + wave * 256);
    const int sb = lane * 16, swz = sb ^ (((sb >> 9) & 1) << 5), srow = 16 * (wave >> 1) + (swz >> 6), scol = 32 * (wave & 1) + ((swz & 63) >> 1);
    const unsigned koff = (unsigned)(srow * 8 * DQK * 2 + scol * 2);
    const unsigned voff = (unsigned)(srow * T * 2 + scol * 2);
    const int rk = (r * 64 + g * 16) ^ ((r >> 3) << 5);
    const int rv0 = (r * 64 + g * 8) ^ ((r >> 3) << 5), rv1 = rv0 ^ 32;
#define ATT_WAIT(n_) asm volatile("s_waitcnt vmcnt(" #n_ ")" ::: "memory")
    for (int unit = C.bid; unit < 256; unit += C.G) {
        const int pbh = (unit & 7) + 8 * (unit >> 6), b = pbh >> 3, h = pbh & 7, x = (unit >> 3) & 7;
        const int qblk = (wave >> 2) ? (15 - x) : x, q0 = qblk * 128 + (wave & 3) * 32;
        const int nkt = 2 * (16 - x), my_last = (q0 + 31) >> 6;
        bf16x8 qf[2][NC];
#pragma unroll
        for (int mt = 0; mt < 2; ++mt)
#pragma unroll
            for (int c = 0; c < NC; ++c) qf[mt][c] = *(const bf16x8*)(Q + ((size_t)(b * T + q0 + 16 * mt + r) * 8 + h) * DQK + 32 * c + 8 * g);
        f32x4 Oa[2][8];
#pragma unroll
        for (int mt = 0; mt < 2; ++mt)
#pragma unroll
            for (int n = 0; n < 8; ++n) Oa[mt][n] = (f32x4){0.f, 0.f, 0.f, 0.f};
        float mrun[2] = {-INFINITY, -INFINITY}, lrun[2] = {0.f, 0.f};
        const char* Kb = (const char*)(K + ((size_t)(b * T) * 8 + h) * DQK); const char* Vb = (const char*)(Vt + (size_t)((b * 8 + h) * 128) * T);
        const char* selb = SPARSE ? (const char*)(sel + (size_t)(b * T + q0 + (lane >> 1)) * 32) + (lane & 1) * 4 : nullptr;
#define ATT_DMA(gp_, la_) asm volatile("s_mov_b32 m0, %0\n\ts_nop 0\n\tglobal_load_lds_dwordx4 %1, off" :: "s"(la_), "v"(gp_) : "memory", "m0")
#define ATT_LOAD(kt_, buf_) do { const unsigned lb_ = __builtin_amdgcn_readfirstlane(ldsw + (unsigned)((buf_) * KTB)), lv_ = __builtin_amdgcn_readfirstlane(ldsw + (unsigned)(3 * KTB + (buf_) * VTB)); \
        _Pragma("unroll") for (int cb_ = 0; cb_ < NCB; ++cb_) ATT_DMA(Kb + (size_t)(kt_) * (64 * 8 * DQK * 2) + koff + cb_ * 128, lb_ + cb_ * 8192); \
        _Pragma("unroll") for (int rb_ = 0; rb_ < 2; ++rb_) ATT_DMA(Vb + (size_t)(kt_) * 128 + voff + rb_ * (64 * T * 2), lv_ + rb_ * 8192); \
        if (SPARSE) { const unsigned lm_ = __builtin_amdgcn_readfirstlane(ldsm + (unsigned)((buf_) * MSB)); \
            asm volatile("s_mov_b32 m0, %0\n\ts_nop 0\n\tglobal_load_lds_dword %1, off" :: "s"(lm_), "v"(selb + (size_t)(kt_) * 8) : "memory", "m0"); } } while (0)
        __builtin_amdgcn_s_waitcnt(0x0070); asm volatile("" ::: "memory"); __builtin_amdgcn_s_barrier();
        ATT_LOAD(0, 0);
        if (nkt > 1) ATT_LOAD(1, 1);
        ATT_WAIT(0);
        __builtin_amdgcn_s_barrier();
        int cb = 0;
        for (int kt = 0; kt < nkt; ++kt) {
            const bool more2 = kt + 2 < nkt; const int nb2 = (cb == 0) ? 2 : cb - 1;
            if (more2) ATT_LOAD(kt + 2, nb2);
            if (kt <= my_last) {
                const LAS unsigned char* kb = lds + cb * KTB + rk; const LAS unsigned char* vb = lds + 3 * KTB + cb * VTB;
                f32x4 S[2][4];
#pragma unroll
                for (int mt = 0; mt < 2; ++mt)
#pragma unroll
                    for (int s4 = 0; s4 < 4; ++s4) S[mt][s4] = (f32x4){0.f, 0.f, 0.f, 0.f};
#define KFRAG(i_) (*(const LAS bf16x8*)(kb + (((i_) >> 2) >> 1) * 8192 + (((i_) & 3) * 2 + (((i_) >> 2) & 1)) * 1024))
#define VFRAG(j_, dst_) do { const LAS unsigned char* vp_ = vb + (((j_) & 7) >> 2) * 8192 + ((((j_) & 7) & 3) * 2 + ((j_) >> 3)) * 1024; const u32x2 v0_ = *(const LAS u32x2*)(vp_ + rv0), v1_ = *(const LAS u32x2*)(vp_ + rv1); \
                    u32x4 w_; w_.x = v0_.x; w_.y = v0_.y; w_.z = v1_.x; w_.w = v1_.y; dst_ = __builtin_bit_cast(bf16x8, w_); } while (0)
                constexpr int PD = 4, RG = PD + 1, NS = 4 * NC;
                bf16x8 kr[RG];
#pragma unroll
                for (int i = 0; i < PD; ++i) kr[i] = KFRAG(i);
                __builtin_amdgcn_sched_barrier(0);
#pragma unroll
                for (int i = 0; i < NS; ++i) { const int c = i >> 2, s4 = i & 3;
                    if (i + PD < NS) kr[(i + PD) % RG] = KFRAG(i + PD);
                    S[0][s4] = __builtin_amdgcn_mfma_f32_16x16x32_bf16(kr[i % RG], qf[0][c], S[0][s4], 0, 0, 0); S[1][s4] = __builtin_amdgcn_mfma_f32_16x16x32_bf16(kr[i % RG], qf[1][c], S[1][s4], 0, 0, 0);
                    __builtin_amdgcn_sched_barrier(0); }
                bf16x8 vr[RG];
#pragma unroll
                for (int j = 0; j < PD; ++j) VFRAG(j, vr[j]);
                __builtin_amdgcn_sched_barrier(0);
                bf16x8 pf[2][2];
                const bool diag = (64 * kt + 63 > q0);
                u32x2 wsel[2] = {(u32x2){0u, 0u}, (u32x2){0u, 0u}};
                if (SPARSE) { const LAS unsigned char* mb = lds + MOFF + cb * MSB + wave * 256 + r * 8; wsel[0] = *(const LAS u32x2*)mb; wsel[1] = *(const LAS u32x2*)(mb + 128); }
#pragma unroll
                for (int mt = 0; mt < 2; ++mt) {
                    const int qrow = q0 + 16 * mt + r; float mx = -INFINITY;
                    if (SPARSE || diag) {
#pragma unroll
                        for (int s4 = 0; s4 < 4; ++s4) {
                            unsigned nib = 0u; if (SPARSE) { const unsigned hw_ = (s4 < 2) ? wsel[mt].x : wsel[mt].y; nib = (hw_ >> (16 * (s4 & 1) + 4 * g)) & 15u; }
#pragma unroll
                            for (int i = 0; i < 4; ++i) { bool ok;
                                if (SPARSE) ok = (nib >> i) & 1u; else ok = (64 * kt + 16 * s4 + 4 * g + i <= qrow);
                                S[mt][s4][i] = ok ? S[mt][s4][i] : -INFINITY; } } }
#pragma unroll
                    for (int s4 = 0; s4 < 4; ++s4)
#pragma unroll
                        for (int i = 0; i < 4; ++i) mx = fmaxf(mx, S[mt][s4][i]);
                    mx = fmaxf(mx, __shfl_xor(mx, 16)); mx = fmaxf(mx, __shfl_xor(mx, 32));
                    const float mnew = fmaxf(mrun[mt], mx), msafe = (mnew == -INFINITY) ? 0.f : mnew, ml = msafe * LOG2E;
                    const float alpha = __builtin_amdgcn_exp2f((mrun[mt] - msafe) * LOG2E); mrun[mt] = mnew;
                    float ps = 0.f;
#pragma unroll
                    for (int s4 = 0; s4 < 4; ++s4)
#pragma unroll
                        for (int i = 0; i < 4; ++i) { const float p = __builtin_amdgcn_exp2f(S[mt][s4][i] * LOG2E - ml); S[mt][s4][i] = p; ps += p; }
                    lrun[mt] = lrun[mt] * alpha + ps;
                    if (__builtin_amdgcn_ballot_w64(alpha != 1.0f)) {
#pragma unroll
                        for (int n = 0; n < 8; ++n) Oa[mt][n] = Oa[mt][n] * alpha; }
#pragma unroll
                    for (int c = 0; c < 2; ++c) { u32x4 w; w.x = pk2(S[mt][2 * c][0], S[mt][2 * c][1]); w.y = pk2(S[mt][2 * c][2], S[mt][2 * c][3]); w.z = pk2(S[mt][2 * c + 1][0], S[mt][2 * c + 1][1]); w.w = pk2(S[mt][2 * c + 1][2], S[mt][2 * c + 1][3]);
                        pf[mt][c] = __builtin_bit_cast(bf16x8, w); }
                }
                __builtin_amdgcn_sched_barrier(0);
#pragma unroll
                for (int j = 0; j < 16; ++j) { const int c = j >> 3, n = j & 7;
                    if (j + PD < 16) VFRAG(j + PD, vr[(j + PD) % RG]);
                    Oa[0][n] = __builtin_amdgcn_mfma_f32_16x16x32_bf16(vr[j % RG], pf[0][c], Oa[0][n], 0, 0, 0); Oa[1][n] = __builtin_amdgcn_mfma_f32_16x16x32_bf16(vr[j % RG], pf[1][c], Oa[1][n], 0, 0, 0);
                    __builtin_amdgcn_sched_barrier(0); }
#undef KFRAG
#undef VFRAG
            }
            if (more2) asm volatile("s_waitcnt vmcnt(%0)" :: "n"(NP) : "memory"); else ATT_WAIT(0);
            asm volatile("s_waitcnt lgkmcnt(0)" ::: "memory"); __builtin_amdgcn_s_barrier();
            cb = (cb == 2) ? 0 : cb + 1;
        }
#pragma unroll
        for (int mt = 0; mt < 2; ++mt) { float l = lrun[mt]; l += __shfl_xor(l, 16); l += __shfl_xor(l, 32); const float inv = 1.0f / l;
            bf16* op = O + (size_t)(b * T + q0 + 16 * mt + r) * 1024 + h * 128 + 4 * g;
#pragma unroll
            for (int n = 0; n < 8; ++n) { const f32x4 o = Oa[mt][n] * inv; u32x2 w; w.x = pk2(o[0], o[1]); w.y = pk2(o[2], o[3]); *(u32x2*)(op + 16 * n) = w; } }
#undef ATT_LOAD
#undef ATT_DMA
    }
#undef ATT_WAIT
    __syncthreads();
}

__device__ __forceinline__ void indexer_mfma(Ctx& C, const bf16* proj, const bf16* qi, const bf16* ki, u64* sel) {
    LAS float* scw = (LAS float*)(C.lds + C.wave * 16384);
    const int gw = C.bid * 8 + C.wave, NGW = C.G * 8, lane = C.lane, r = lane & 15, g = lane >> 4;
    for (int P = gw, it = 0; P < M / 2; P += NGW, ++it) {
        const int b = P >> 10, pp = P & 1023, t0 = (it & 1) ? (2046 - 2 * pp) : (2 * pp), m0 = b * T + t0;
        if (t0 + 2 > 256) {
            bf16x8 a0[2], a1[2]; float w0[2], w1[2], w2[2], w3[2];
#pragma unroll
            for (int q = 0; q < 2; ++q) { a0[q] = *(const bf16x8*)(qi + (size_t)(m0 + q) * 1024 + r * 64 + 8 * g); a1[q] = *(const bf16x8*)(qi + (size_t)(m0 + q) * 1024 + r * 64 + 32 + 8 * g);
                const u32x2 ww = *(const u32x2*)(proj + (size_t)(m0 + q) * PROJ_N + PX_IW + 4 * g); w0[q] = bflo(ww.x); w1[q] = bfhi(ww.x); w2[q] = bflo(ww.y); w3[q] = bfhi(ww.y); }
            const int njj = ((t0 + 1) >> 6) + 1;
            const bf16* kp = ki + (size_t)(b * T + r) * 64 + 8 * g; bf16x8 kb[4][2], kn[4][2];
#pragma unroll
            for (int s4 = 0; s4 < 4; ++s4) { kb[s4][0] = *(const bf16x8*)(kp + s4 * 16 * 64); kb[s4][1] = *(const bf16x8*)(kp + s4 * 16 * 64 + 32); }
#pragma nounroll
            for (int jj = 0; jj < njj; ++jj) {
                const bf16* kq = kp + (size_t)((jj + 1 < njj) ? (jj + 1) : jj) * 64 * 64;
#pragma unroll
                for (int s4 = 0; s4 < 4; ++s4) { kn[s4][0] = *(const bf16x8*)(kq + s4 * 16 * 64); kn[s4][1] = *(const bf16x8*)(kq + s4 * 16 * 64 + 32); }
                float val[2] = {0.f, 0.f};
#pragma unroll
                for (int s4 = 0; s4 < 4; ++s4)
#pragma unroll
                    for (int q = 0; q < 2; ++q) { f32x4 d = (f32x4){0.f, 0.f, 0.f, 0.f};
                        d = __builtin_amdgcn_mfma_f32_16x16x32_bf16(a0[q], kb[s4][0], d, 0, 0, 0); d = __builtin_amdgcn_mfma_f32_16x16x32_bf16(a1[q], kb[s4][1], d, 0, 0, 0);
                        float part = w0[q] * relu_(d[0]) + w1[q] * relu_(d[1]) + w2[q] * relu_(d[2]) + w3[q] * relu_(d[3]);
                        part += __shfl_xor(part, 16); part += __shfl_xor(part, 32);
                        val[q] = (g == s4) ? part : val[q]; }
                scw[jj * 64 + lane] = val[0]; scw[2048 + jj * 64 + lane] = val[1];
#pragma unroll
                for (int s4 = 0; s4 < 4; ++s4) { kb[s4][0] = kn[s4][0]; kb[s4][1] = kn[s4][1]; }
            }
            asm volatile("s_waitcnt lgkmcnt(0)" ::: "memory");
        }
        topk_select(scw, t0, sel + (size_t)m0 * 32, lane);
        topk_select(scw + 2048, t0 + 1, sel + (size_t)(m0 + 1) * 32, lane);
    }
}

__device__ __forceinline__ void lru_scan(Ctx& C, const bf16* la, const bf16* lb, const bf16* proj, bf16* outa) {
    LAS float* cA = (LAS float*)C.lds; LAS float* cB = cA + 512;
    for (int u = C.bid; u < 256; u += C.G) {
        const int b = u >> 6, cg = u & 63, cl = C.tid & 15, chunk = C.tid >> 4, ch = cg * 16 + cl;
        const size_t base = (size_t)(b * T + chunk * 64) * 1024 + ch;
        float A = 1.f, Bv = 0.f;
        unsigned pk[64];
#pragma unroll
        for (int s = 0; s < 64; ++s) pk[s] = (unsigned)__builtin_bit_cast(unsigned short, la[base + (size_t)s * 1024]) | ((unsigned)__builtin_bit_cast(unsigned short, lb[base + (size_t)s * 1024]) << 16);
#pragma unroll
        for (int s = 0; s < 64; ++s) { const float a = 1.0f - bflo(pk[s]), bb = bfhi(pk[s]); Bv = a * Bv + bb; A *= a; }
        __syncthreads();
        cA[chunk * 16 + cl] = A; cB[chunk * 16 + cl] = Bv;
        __syncthreads();
        float H = 0.f;
        for (int j = 0; j < chunk; ++j) H = cA[j * 16 + cl] * H + cB[j * 16 + cl];
#pragma unroll
        for (int s = 0; s < 64; ++s) { const float a = 1.0f - bflo(pk[s]), bb = bfhi(pk[s]); H = a * H + bb;
            const size_t m = (size_t)(b * T + chunk * 64 + s); const float g = bf2f(proj[m * PROJ_N + PX_LRUG + ch]); outa[m * 1024 + ch] = f2bf(H * gelu_tanh(g)); }
    }
    __syncthreads();
}

__device__ __forceinline__ void mla_post(Ctx& C, const bf16* proj, const int* pos, const bf16* qmr, const bf16* kvmr, const float* qn, const float* kn, bf16* qm, bf16* km) {
    const int gw = C.bid * 8 + C.wave, NGW = C.G * 8, lane = C.lane, i = lane & 31;
    const float QMSCALE = 0.07216878364870323f;
    for (int m = gw; m < M; m += NGW) {
        float sn, cs; rope_sc((float)pos[m], i, 64, sn, cs);
        const float kr1 = bf2f(proj[(size_t)m * PROJ_N + PX_KR + i]), kr2 = bf2f(proj[(size_t)m * PROJ_N + PX_KR + 32 + i]);
#pragma unroll
        for (int h = 0; h < 8; ++h) {
            { const bf16* q = qmr + (size_t)m * 1536 + h * 192; const float x0 = bf2f(q[lane]), x1 = bf2f(q[64 + lane]), r1 = bf2f(q[128 + i]), r2 = bf2f(q[160 + i]);
              const float ss = wave_sum(x0 * x0 + x1 * x1 + (lane < 32 ? r1 * r1 + r2 * r2 : 0.f)); const float rstd = 1.0f / sqrtf(ss * (1.0f / 192.0f) + EPS) * QMSCALE;
              bf16* o = qm + (size_t)m * 1536 + h * 192; o[lane] = f2bf(x0 * rstd * qn[lane]); o[64 + lane] = f2bf(x1 * rstd * qn[64 + lane]);
              const float z1 = r1 * rstd * qn[128 + i], z2 = r2 * rstd * qn[160 + i]; if (lane < 32) { o[128 + i] = f2bf(z1 * cs - z2 * sn); o[160 + i] = f2bf(z2 * cs + z1 * sn); } }
            { const bf16* k = kvmr + (size_t)m * 2048 + h * 256; const float x0 = bf2f(k[lane]), x1 = bf2f(k[64 + lane]);
              const float ss = wave_sum(x0 * x0 + x1 * x1 + (lane < 32 ? kr1 * kr1 + kr2 * kr2 : 0.f)); const float rstd = 1.0f / sqrtf(ss * (1.0f / 192.0f) + EPS);
              bf16* o = km + (size_t)m * 1536 + h * 192; o[lane] = f2bf(x0 * rstd * kn[lane]); o[64 + lane] = f2bf(x1 * rstd * kn[64 + lane]);
              const float z1 = kr1 * rstd * kn[128 + i], z2 = kr2 * rstd * kn[160 + i]; if (lane < 32) { o[128 + i] = f2bf(z1 * cs - z2 * sn); o[160 + i] = f2bf(z2 * cs + z1 * sn); } }
        }
    }
}

__device__ __forceinline__ void moe_route(Ctx& C, int* mi) {
    if (C.bid != 0) return;
    LAS int* hist = (LAS int*)C.lds;
    LAS int* tot = hist + 8 * 512;
    const int* toke = mi + MI_TOKE; const float* tokg = (const float*)(mi + MI_TOKG); int* dest = mi + MI_DEST; int* rowtok = mi + MI_ROWTOK; float* rowg = (float*)(mi + MI_ROWG); int* blke = mi + MI_BLKE;
    const int tid = C.tid, lane = C.lane;
    for (int i = tid; i < MOE_ROWS; i += 512) { rowtok[i] = M; rowg[i] = 0.f; }
    int cnt[8];
#pragma unroll
    for (int e = 0; e < 8; ++e) cnt[e] = 0;
    for (int j = 0; j < 32; ++j) { const int ee = toke[tid * 32 + j];
#pragma unroll
        for (int e = 0; e < 8; ++e) cnt[e] += (ee == e) ? 1 : 0; }
#pragma unroll
    for (int e = 0; e < 8; ++e) hist[e * 512 + tid] = cnt[e];
    __syncthreads();
    { const int e = C.wave; int v[8]; int s = 0;
#pragma unroll
      for (int j = 0; j < 8; ++j) { v[j] = hist[e * 512 + lane * 8 + j]; s += v[j]; }
      int incl = s;
#pragma unroll
      for (int o = 1; o < 64; o <<= 1) { const int y = __shfl_up(incl, o); if (lane >= o) incl += y; }
      int run = incl - s;
#pragma unroll
      for (int j = 0; j < 8; ++j) { hist[e * 512 + lane * 8 + j] = run; run += v[j]; }
      if (lane == 63) tot[e] = incl; }
    __syncthreads();
    int base[8]; int ps = 0; int pend[8];
#pragma unroll
    for (int e = 0; e < 8; ++e) { const int pad = (tot[e] + 255) / 256 * 256; base[e] = ps + hist[e * 512 + tid]; ps += pad; pend[e] = ps; }
    for (int j = 0; j < 32; ++j) { const int a = tid * 32 + j; const int ee = toke[a]; int d = 0;
#pragma unroll
        for (int e = 0; e < 8; ++e) if (ee == e) { d = base[e]; base[e] += 1; }
        dest[a] = d; rowtok[d] = a >> 1; rowg[d] = tokg[a]; }
    if (tid < MOE_BLKS) { int e = 0;
#pragma unroll
        for (int q = 0; q < 8; ++q) e += (pend[q] <= tid * 256) ? 1 : 0;
        blke[tid] = e > 7 ? 7 : e; }
    if (tid == 0) { mi[MI_NUSED] = ps / 256; mi[MI_BSTART] = 0; }
    if (tid < 8) { int pe = 0;
#pragma unroll
        for (int q = 0; q < 8; ++q) pe = (tid == q) ? pend[q] : pe;
        mi[MI_BSTART + 1 + tid] = pe / 256; }
    __syncthreads();
}
__device__ __forceinline__ void moe_gather_fp8(Ctx& C, const int* mi, const bf16* hn, unsigned char* xs) {
    const int gw = C.bid * 8 + C.wave, NGW = C.G * 8, lane = C.lane; const int nrows = mi[MI_NUSED] * 256; const int* rowtok = mi + MI_ROWTOK;
    for (int r = gw; r < nrows; r += NGW) { const int tok = rowtok[r]; u32x4* o = (u32x4*)(xs + (size_t)r * D + lane * 32);
        if (tok < M) { const u32x4* sp = (const u32x4*)(hn + (size_t)tok * D + lane * 32); u32x4 ov[2];
#pragma unroll
            for (int h2 = 0; h2 < 2; ++h2) { const u32x4 a = sp[2 * h2], b = sp[2 * h2 + 1];
                ov[h2].x = pk4_fp8(bflo(a.x) * F8_XSCALE, bfhi(a.x) * F8_XSCALE, bflo(a.y) * F8_XSCALE, bfhi(a.y) * F8_XSCALE); ov[h2].y = pk4_fp8(bflo(a.z) * F8_XSCALE, bfhi(a.z) * F8_XSCALE, bflo(a.w) * F8_XSCALE, bfhi(a.w) * F8_XSCALE);
                ov[h2].z = pk4_fp8(bflo(b.x) * F8_XSCALE, bfhi(b.x) * F8_XSCALE, bflo(b.y) * F8_XSCALE, bfhi(b.y) * F8_XSCALE); ov[h2].w = pk4_fp8(bflo(b.z) * F8_XSCALE, bfhi(b.z) * F8_XSCALE, bflo(b.w) * F8_XSCALE, bfhi(b.w) * F8_XSCALE); }
            o[0] = ov[0]; o[1] = ov[1]; }
        else { o[0] = (u32x4){0u, 0u, 0u, 0u}; o[1] = (u32x4){0u, 0u, 0u, 0u}; } }
}
__device__ __forceinline__ void moe_gather(Ctx& C, const int* mi, const bf16* hn, bf16* xs) {
    const int gw = C.bid * 8 + C.wave, NGW = C.G * 8, lane = C.lane; const int nrows = mi[MI_NUSED] * 256; const int* rowtok = mi + MI_ROWTOK;
    for (int r = gw; r < nrows; r += NGW) { const int tok = rowtok[r]; u32x4* o = (u32x4*)(xs + (size_t)r * D) + lane;
        if (tok < M) { const u32x4* s = (const u32x4*)(hn + (size_t)tok * D) + lane;
#pragma unroll
            for (int j = 0; j < 4; ++j) o[64 * j] = s[64 * j]; }
        else {
#pragma unroll
            for (int j = 0; j < 4; ++j) o[64 * j] = (u32x4){0u, 0u, 0u, 0u}; } }
}
__device__ __forceinline__ void moe_combine(Ctx& C, const int* mi, const bf16* ys, bf16* h) {
    const int gw = C.bid * 8 + C.wave, NGW = C.G * 8, lane = C.lane; const int* dest = mi + MI_DEST;
    for (int m = gw; m < M; m += NGW) { const int d0 = dest[2 * m], d1 = dest[2 * m + 1];
        u32x2* hp = (u32x2*)(h + (size_t)m * D) + lane; const u32x2* y0 = (const u32x2*)(ys + (size_t)d0 * D) + lane; const u32x2* y1 = (const u32x2*)(ys + (size_t)d1 * D) + lane;
        const size_t slab = (size_t)MOE_ROWS * D / 4;
#pragma unroll
        for (int j = 0; j < 8; ++j) { const u32x2 hw = hp[64 * j], a0 = y0[64 * j], a1 = y0[slab + 64 * j], b0 = y1[64 * j], b1 = y1[slab + 64 * j];
            u32x2 w; w.x = pk2(bflo(hw.x) + ((bflo(a0.x) + bflo(a1.x)) + (bflo(b0.x) + bflo(b1.x))), bfhi(hw.x) + ((bfhi(a0.x) + bfhi(a1.x)) + (bfhi(b0.x) + bfhi(b1.x))));
            w.y = pk2(bflo(hw.y) + ((bflo(a0.y) + bflo(a1.y)) + (bflo(b0.y) + bflo(b1.y))), bfhi(hw.y) + ((bfhi(a0.y) + bfhi(a1.y)) + (bfhi(b0.y) + bfhi(b1.y)))); hp[64 * j] = w; } }
}

constexpr int CW_BGQ = 8192;
constexpr int BG_I1 = 56 * 16, BG_I2 = 8 * 56, BG_N1 = 8 * BG_I1, BG_NITEMS = BG_N1 + 8 * BG_I2;
__device__ __forceinline__ void bg_conv_item(LAS unsigned char* tile, int tid, int w, int L, KArgPtr ka, int item) {
    const float* src; ptrdiff_t du = 0; int srcN, K, n0, k0; unsigned char* dst;
    if (item < BG_N1) { const int e = item / BG_I1, rr = item - e * BG_I1, nb = rr >> 4, kb = rr & 15; n0 = nb * 256; k0 = kb * 128; srcN = EFF; K = 2048;
        src = (const float*)ka->in[27] + (size_t)e * 2048 * EFF; du = (const float*)ka->in[28] - (const float*)ka->in[27]; dst = ka->ws + O_WM1 + (size_t)e * (SZ_WM1 / 2); }
    else { const int j = item - BG_N1, e = j / BG_I2, rr = j - e * BG_I2, nb = rr / 56, kb = rr - nb * 56; n0 = nb * 256; k0 = kb * 128; srcN = 2048; K = EFF;
        src = (const float*)ka->in[29] + (size_t)e * EFF * 2048; dst = ka->ws + O_WM2 + (size_t)e * (SZ_WM2 / 2); }
    const float* sp;
    if (item < BG_N1) { const int n = n0 + 4 * L, tl = n >> 8, r = n & 255; sp = src + (r < 128 ? (ptrdiff_t)0 : du) + tl * 128 + (r & 127); } else sp = src + n0 + 4 * L;
    f32x4 v[16];
#pragma unroll
    for (int j = 0; j < 16; ++j) v[j] = __builtin_nontemporal_load((const f32x4*)(sp + (size_t)(k0 + 16 * w + j) * srcN));
#pragma unroll
    for (int q = 0; q < 4; ++q) { u32x4 o; o.x = pk4_fp8(v[0][q] * F8_WSCALE, v[1][q] * F8_WSCALE, v[2][q] * F8_WSCALE, v[3][q] * F8_WSCALE); o.y = pk4_fp8(v[4][q] * F8_WSCALE, v[5][q] * F8_WSCALE, v[6][q] * F8_WSCALE, v[7][q] * F8_WSCALE);
        o.z = pk4_fp8(v[8][q] * F8_WSCALE, v[9][q] * F8_WSCALE, v[10][q] * F8_WSCALE, v[11][q] * F8_WSCALE); o.w = pk4_fp8(v[12][q] * F8_WSCALE, v[13][q] * F8_WSCALE, v[14][q] * F8_WSCALE, v[15][q] * F8_WSCALE);
        *(LAS u32x4*)(tile + (4 * L + q) * 144 + w * 16) = o; }
    __syncthreads();
#pragma unroll
    for (int i = 0; i < 4; ++i) { const int idx = tid + 512 * i, n = idx >> 3, ch = idx & 7; const u32x4 o = *(const LAS u32x4*)(tile + n * 144 + ch * 16); *(u32x4*)(dst + (size_t)(n0 + n) * K + k0 + ch * 16) = o; }
    __syncthreads();
}
__device__ __forceinline__ void bg_drain(LAS unsigned char* lds, volatile LAS unsigned* misc, int wave, KArgPtr ka) {
    int ln; asm volatile("v_mbcnt_lo_u32_b32 %0, -1, 0\n\tv_mbcnt_hi_u32_b32 %0, -1, %0" : "=v"(ln));
    const int tid = wave * 64 + ln; unsigned* q = (unsigned*)(ka->ws) + CW_BGQ;
    for (;;) {
        if (tid == 0) misc[4] = xb_add(q, 1u);
        __syncthreads();
        const int item = (int)misc[4];
        __syncthreads();
        if (item >= BG_NITEMS) break;
        bg_conv_item(lds, tid, wave, ln, ka, item);
    }
}
__device__ __forceinline__ void xcd_barrier_bg(const XcdBarrier& b, LAS unsigned char* lds, KArgPtr ka) {
    asm volatile("s_waitcnt vmcnt(0)" ::: "memory");
    __syncthreads();
    volatile LAS unsigned* st = b.st;
    const bool t0 = xb_thread0(b.wave);
    if (t0) {
        unsigned* bar = b.bar; unsigned bx = b.x;
        asm volatile("" : "+s"(bar), "+s"(bx));
        __builtin_amdgcn_s_waitcnt(0);
        unsigned nloc = st[0], nx = st[1];
        if (nloc == 0u) { xcd_barrier_complete(bar, bx, nloc, nx); st[0] = nloc; st[1] = nx; }
        const unsigned old = xb_add(&bar[XB_XSUB(bx)], 1u);
        const unsigned gen = old / nloc;
        if (old + 1u == (gen + 1u) * nloc) {
            __builtin_amdgcn_fence(__ATOMIC_RELEASE, "agent");
            asm volatile("s_waitcnt vmcnt(0)" ::: "memory");
            const unsigned og = xb_add(&bar[XB_TOP], 1u);
            const unsigned tg = og / nx;
            if (og + 1u == (tg + 1u) * nx) xb_add(&bar[XB_TOPGEN], 1u);
            else XB_SPIN(xb_ld(&bar[XB_TOPGEN]) == tg, bar);
            __builtin_amdgcn_fence(__ATOMIC_ACQUIRE, "agent");
            xb_add(&bar[XB_XGEN(bx)], 1u);
            asm volatile("s_waitcnt vmcnt(0)" ::: "memory");
            st[2] = 0u;
        } else { st[2] = 2u; st[3] = gen; }
    }
    __syncthreads();
    if (st[2] != 0u) {
        int ln; asm volatile("v_mbcnt_lo_u32_b32 %0, -1, 0\n\tv_mbcnt_hi_u32_b32 %0, -1, %0" : "=v"(ln));
        const int tid = b.wave * 64 + ln; const unsigned gen = st[3];
        unsigned* bar = b.bar; unsigned bx = b.x; asm volatile("" : "+s"(bar), "+s"(bx));
        unsigned* q = bar - CW_BAR + CW_BGQ;
        bool qempty = (BG_NOWAITWORK != 0); unsigned spins = 0u;
        for (;;) {
            if (t0) { unsigned code = 0u;
                if (xb_ld(&bar[XB_XGEN(bx)]) == gen) { code = 1u;
                    if (!qempty) { const unsigned it = xb_add(q, 1u); if (it < (unsigned)BG_NITEMS) code = 2u + it; else qempty = true; }
                    if (code == 1u) { __builtin_amdgcn_s_sleep(2); if ((++spins & 255u) == 0u) { if (xb_ld(&bar[XB_TMO])) code = 0u; else if (spins > (XB_SPIN_CAP << 2)) { atomicAdd(&bar[XB_TMO], 1u); code = 0u; } } } }
                st[4] = code; }
            __syncthreads();
            const unsigned code = st[4];
            __syncthreads();
            if (code == 0u) break;
            if (code >= 2u) bg_conv_item(lds, tid, b.wave, ln, ka, (int)(code - 2u));
        }
        if (t0) { __builtin_amdgcn_fence(__ATOMIC_ACQUIRE, "agent"); asm volatile("s_waitcnt vmcnt(0)" ::: "memory"); }
    }
    __syncthreads();
}

enum { LP_INPROJ = 0, LP_POST, LP_MID1, LP_MID2, LP_MLAATT, LP_BRANCH, LP_WOUT, LP_NORM2, LP_ROUTE, LP_GATHER, LP_FFN1, LP_FFN2, LP_NORM3, LP_PLE, LP_NORM1, NLP };
constexpr int NPH = 1 + 2 * NLP;
__host__ __device__ inline bool phase_active(int ph) {
    if (ph == 0) return true;
    const int l = (ph - 1) / NLP, k = (ph - 1) % NLP;
    if ((k == LP_ROUTE || k == LP_GATHER) && l == 0) return false;
    if (k == LP_NORM1 && l == 1) return false;
    return true;
}

#ifdef ONLY_LP
#define IN(k) (((k) == 0 ? ((ONLY_LP) & 1) : (((ONLY_LP) >> (1 + (((k) - 1) % NLP))) & 1)) && lo <= (k) && (k) < hi)
#else
#define IN(k) (lo <= (k) && (k) < hi)
#endif
#if BG_CONV && FP8_MOE
#define SEAM(k) do { if (multi && (k) + 1 < hi) xcd_barrier_bg(bar, lds0, kargs()); } while (0)
#else
#define SEAM(k) do { if (multi && (k) + 1 < hi) xcd_barrier(bar); } while (0)
#endif
#define INF(i) ((const float*)ka->in[i])

template <int l>
__device__ __forceinline__ void layer_body(const int lo, const int hi, const bool multi, const XcdBarrier& bar, LAS unsigned char* const lds0, const int wave_s) {
        const int p0 = 1 + l * NLP;
        if (IN(p0 + LP_INPROJ)) {
            PHASE_LOCALS;
#if FP8_GATES
            { PlainSched S{WSP(bf16, O_HN), WSP(bf16, O_WIN + l * SZ_WIN), 2048, 2048, 2048, 32, PX_GATE / 256, C.G, C.bid};
              for (int rp = 0; rp < PB(1); ++rp) gemm_run(C, S, EpiBf16{WSP(bf16, O_PROJ), PROJ_N, 0, 1.0f}); }
            { PHASE_LOCALS; PlainSched S{WSP(bf16, O_HN8), WSP(bf16, O_WIN + l * SZ_WIN + (size_t)PX_GATE * 2048 * 2), 1024, 1024, 1024, 32, 24, C.G, C.bid};
              for (int rp = 0; rp < PB(1); ++rp) gemm_run_fp8(C, S, EpiBf16{WSP(bf16, O_PROJ), PROJ_N, PX_GATE, 1.0f / (F8_WSCALE * F8_XSCALE)}); }
#else
            PlainSched S{WSP(bf16, O_HN), WSP(bf16, O_WIN + l * SZ_WIN), 2048, 2048, 2048, 32, PROJ_N / 256, C.G, C.bid};
            for (int rp = 0; rp < PB(1); ++rp) gemm_run(C, S, EpiBf16{WSP(bf16, O_PROJ), PROJ_N, 0, 1.0f});
#endif
            SEAM(p0 + LP_INPROJ);
        }
        if (IN(p0 + LP_POST)) {
            PHASE_LOCALS;
            for (int rp = 0; rp < PB(2); ++rp) postproj_tokens(C, WSP(bf16, O_PROJ), (const int*)ka->in[2], INF(5) + l * 4096, INF(6) + l * 1024, INF(12) + l * 128, INF(13) + l * 128, INF(14) + l * 768, INF(15) + l * 512,
                            WSP(bf16, O_XC), WSP(bf16, O_QS), WSP(bf16, O_KS), WSP(bf16, O_QI), WSP(bf16, O_KI), WSP(bf16, O_CQN), WSP(bf16, O_CKVN));
            for (int rp = 0; rp < PB(3); ++rp) transpose_v(C, WSP(bf16, O_PROJ), PROJ_N, PX_AV, 128, WSP(bf16, O_VTS));
            SEAM(p0 + LP_POST);
        }
        if (IN(p0 + LP_MID1)) {
#ifndef SUBSEL
#define SUBSEL 15
#endif
            if (SUBSEL & 1) { PHASE_LOCALS; LruSched S{WSP(bf16, O_XC), WSP(bf16, O_WLRU + l * SZ_WLRU), 1024, 256, 256, C.G, C.bid};
              for (int rp = 0; rp < PB(4); ++rp) gemm_run(C, S, EpiLru{WSP(bf16, O_LA), WSP(bf16, O_LB), WSP(bf16, O_XC), INF(8) + l * 1024, INF(10) + l * 1024, (const float*)(WSP(int, O_MOEI) + MI_SP8) + l * 1024}); }
            if (SUBSEL & 2) { PHASE_LOCALS; PlainSched S{WSP(bf16, O_CQN), WSP(bf16, O_WUQ + l * SZ_WUQ), 768, 768, 768, 32, 6, C.G, C.bid}; for (int rp = 0; rp < PB(5); ++rp) gemm_run(C, S, EpiBf16{WSP(bf16, O_QMR), 1536, 0, 1.0f}); }
            if (SUBSEL & 4) { PHASE_LOCALS; PlainSched S{WSP(bf16, O_CKVN), WSP(bf16, O_WUKV + l * SZ_WUKV), 512, 512, 512, 32, 8, C.G, C.bid}; for (int rp = 0; rp < PB(5); ++rp) gemm_run(C, S, EpiBf16{WSP(bf16, O_KVMR), 2048, 0, 1.0f}); }
            if (SUBSEL & 8) { PHASE_LOCALS;
#if FAST_IDX
              for (int rp = 0; rp < PB(6); ++rp) indexer_mfma(C, WSP(bf16, O_PROJ), WSP(bf16, O_QI), WSP(bf16, O_KI), WSP(u64, O_SEL));
#else
              indexer_naive(C, WSP(bf16, O_PROJ), WSP(bf16, O_QI), WSP(bf16, O_KI), WSP(u64, O_SEL));
#endif
            }
            SEAM(p0 + LP_MID1);
        }
        if (IN(p0 + LP_MID2)) {
            { PHASE_LOCALS; for (int rp = 0; rp < PB(7); ++rp) lru_scan(C, WSP(bf16, O_LA), WSP(bf16, O_LB), WSP(bf16, O_PROJ), WSP(bf16, O_BR)); }
            { PHASE_LOCALS; for (int rp = 0; rp < PB(8); ++rp) mla_post(C, WSP(bf16, O_PROJ), (const int*)ka->in[2], WSP(bf16, O_QMR), WSP(bf16, O_KVMR), INF(18) + l * 192, INF(19) + l * 192, WSP(bf16, O_QM), WSP(bf16, O_KM));
              for (int rp = 0; rp < PB(8); ++rp) transpose_v(C, WSP(bf16, O_KVMR), 2048, 128, 256, WSP(bf16, O_VTM)); }
            { PHASE_LOCALS;
#if FAST_ATTN_S
              for (int rp = 0; rp < PB(9); ++rp) attn_mfma<128, true>(C, WSP(bf16, O_QS), WSP(bf16, O_KS), WSP(bf16, O_VTS), WSP(u64, O_SEL), WSP(bf16, O_BR) + (size_t)M * 1024);
#else
              sparse_attn_naive(C, WSP(bf16, O_PROJ), WSP(bf16, O_QS), WSP(bf16, O_KS), WSP(u64, O_SEL), WSP(bf16, O_BR) + (size_t)M * 1024);
#endif
            }
            SEAM(p0 + LP_MID2);
        }
        if (IN(p0 + LP_MLAATT)) {
            PHASE_LOCALS;
#if FAST_ATTN_M
            for (int rp = 0; rp < PB(10); ++rp) attn_mfma<192, false>(C, WSP(bf16, O_QM), WSP(bf16, O_KM), WSP(bf16, O_VTM), nullptr, WSP(bf16, O_BR) + (size_t)2 * M * 1024);
#else
            mla_attn_naive(C, WSP(bf16, O_QM), WSP(bf16, O_KM), WSP(bf16, O_KVMR), WSP(bf16, O_BR) + (size_t)2 * M * 1024);
#endif
            SEAM(p0 + LP_MLAATT);
        }
        if (IN(p0 + LP_BRANCH)) {
            PHASE_LOCALS;
            BranchSched S{WSP(bf16, O_BR), WSP(bf16, O_WBR + (size_t)l * 3 * SZ_WBR), 1024, 1024, 1024, C.G, C.bid};
            for (int rp = 0; rp < PB(11); ++rp) gemm_run(C, S, EpiBranch{WSP(bf16, O_PROJ), WSP(bf16, O_MF), WSP(bf16, O_MG)});
            SEAM(p0 + LP_BRANCH);
        }
        if (IN(p0 + LP_WOUT)) {
            PHASE_LOCALS;
            PlainSched S{WSP(bf16, O_MG), WSP(bf16, O_WOUT + l * SZ_WOUT), 2048, 2048, 2048, 32, 8, C.G, C.bid};
            if constexpr (l == 0) gemm_run(C, S, EpiResidT<false, true>{INF(0), WSP(bf16, O_H), D, 1.0f});
            else gemm_run(C, S, EpiResidT<true, true>{WSP(bf16, O_H), WSP(bf16, O_H), D, 1.0f});
            SEAM(p0 + LP_WOUT);
        }
        if (IN(p0 + LP_NORM2)) {
            PHASE_LOCALS; int* mi = WSP(int, O_MOEI);
            for (int rp = 0; rp < PB(12); ++rp)
            if (l == 0) rmsnorm_rows<false, (FP8_DENSE != 0) ? 1 : 0>(C, WSP(bf16, O_H), INF(22) + l * D, WSP(bf16, O_HN), nullptr, nullptr, nullptr);
            else rmsnorm_rows<true>(C, WSP(bf16, O_H), INF(22) + l * D, WSP(bf16, O_HN), INF(26), mi + MI_TOKE, (float*)(mi + MI_TOKG));
            SEAM(p0 + LP_NORM2);
        }
        if (l == 0) {
            if (IN(p0 + LP_FFN1)) {
                PHASE_LOCALS;
#if FP8_DENSE
                PlainSched S{WSP(bf16, O_HN), WSP(bf16, O_WD1), 1024, 1024, 1024, 32, 2 * DFF / 256, C.G, C.bid};
                for (int rp = 0; rp < PB(13); ++rp) gemm_run_fp8(C, S, EpiSwigluF8{WSP(unsigned char, O_HMID), DFF, 1.0f / (F8_WSCALE * F8_XSCALE)});
#else
                PlainSched S{WSP(bf16, O_HN), WSP(bf16, O_WD1), 2048, 2048, 2048, 32, 2 * DFF / 256, C.G, C.bid};
                for (int rp = 0; rp < PB(13); ++rp) gemm_run(C, S, EpiSwiglu{WSP(bf16, O_HMID), DFF});
#endif
                SEAM(p0 + LP_FFN1);
            }
            if (IN(p0 + LP_FFN2)) {
                PHASE_LOCALS;
#if FP8_DENSE
                PlainSched S{WSP(bf16, O_HMID), WSP(bf16, O_WD2), DFF / 2, DFF / 2, DFF / 2, 32, 8, C.G, C.bid};
                gemm_run_fp8(C, S, EpiResidT<true, true>{WSP(bf16, O_H), WSP(bf16, O_H), D, 1.0f / (F8_WSCALE * F8_HSCALE)});
#else
                PlainSched S{WSP(bf16, O_HMID), WSP(bf16, O_WD2), DFF, DFF, DFF, 32, 8, C.G, C.bid};
                gemm_run(C, S, EpiResidT<true, true>{WSP(bf16, O_H), WSP(bf16, O_H), D, 1.0f});
#endif
                SEAM(p0 + LP_FFN2);
            }
        } else {
            if (IN(p0 + LP_ROUTE)) { PHASE_LOCALS; for (int rp = 0; rp < PB(16); ++rp) moe_route(C, WSP(int, O_MOEI)); SEAM(p0 + LP_ROUTE); }
            if (IN(p0 + LP_GATHER)) { PHASE_LOCALS;
#if BG_CONV && FP8_MOE
              if (multi) bg_drain(lds0, bar.st, wave_s, ka);
#endif
              for (int rp = 0; rp < PB(16); ++rp)
#if FP8_MOE
                moe_gather_fp8(C, WSP(int, O_MOEI), WSP(bf16, O_HN), WSP(unsigned char, O_XS));
#else
                moe_gather(C, WSP(int, O_MOEI), WSP(bf16, O_HN), WSP(bf16, O_XS));
#endif
              SEAM(p0 + LP_GATHER); }
            if (IN(p0 + LP_FFN1)) {
                PHASE_LOCALS; int* mi = WSP(int, O_MOEI);
#if FP8_MOE
                MoeSched S{WSP(bf16, O_XS), WSP(bf16, O_WM1), 1024, 1024, 1024, 2 * EFF / 256, 4, 1, C.G, C.bid, mi + MI_BLKE, mi + MI_BSTART, mi[MI_NUSED], (size_t)EFF * 2048};
                for (int rp = 0; rp < PB(14); ++rp) gemm_run_fp8(C, S, EpiSwigluF8{WSP(unsigned char, O_HMID), EFF, 1.0f / (F8_WSCALE * F8_XSCALE)});
#else
                MoeSched S{WSP(bf16, O_XS), WSP(bf16, O_WM1), 2048, 2048, 2048, 2 * EFF / 256, 4, 1, C.G, C.bid, mi + MI_BLKE, mi + MI_BSTART, mi[MI_NUSED], (size_t)2 * EFF * 2048};
                for (int rp = 0; rp < PB(14); ++rp) gemm_run(C, S, EpiSwiglu{WSP(bf16, O_HMID), EFF});
#endif
                SEAM(p0 + LP_FFN1);
            }
            if (IN(p0 + LP_FFN2)) {
                PHASE_LOCALS; int* mi = WSP(int, O_MOEI);
#if FP8_MOE
                MoeSched S{WSP(bf16, O_HMID), WSP(bf16, O_WM2), EFF / 2, EFF / 2, EFF / 4, 8, 8, 2, C.G, C.bid, mi + MI_BLKE, mi + MI_BSTART, mi[MI_NUSED], (size_t)1024 * EFF};
                for (int rp = 0; rp < PB(15); ++rp) gemm_run_fp8(C, S, EpiScaleRow{WSP(bf16, O_YS), (const float*)(mi + MI_ROWG), 1.0f / (F8_WSCALE * F8_HSCALE)});
#else
                MoeSched S{WSP(bf16, O_HMID), WSP(bf16, O_WM2), EFF, EFF, EFF / 2, 8, 8, 2, C.G, C.bid, mi + MI_BLKE, mi + MI_BSTART, mi[MI_NUSED], (size_t)2048 * EFF};
                for (int rp = 0; rp < PB(15); ++rp) gemm_run(C, S, EpiScaleRow{WSP(bf16, O_YS), (const float*)(mi + MI_ROWG), 1.0f});
#endif
                SEAM(p0 + LP_FFN2);
            }
        }
        if (IN(p0 + LP_NORM3)) {
            { PHASE_LOCALS;
              if (l == 1) { moe_combine(C, WSP(int, O_MOEI), WSP(bf16, O_YS), WSP(bf16, O_H)); asm volatile("s_waitcnt vmcnt(0)" ::: "memory"); }
              rmsnorm_rows<false>(C, WSP(bf16, O_H), INF(30) + l * D, WSP(bf16, O_HN), nullptr, nullptr, nullptr); }
            { PHASE_LOCALS; PlainSched S{WSP(bf16, O_PBF + l * SZ_PBF), WSP(bf16, O_WPP + l * SZ_WPP), 256, 256, 256, 32, 8, C.G, C.bid}; for (int rp = 0; rp < PB(17); ++rp) gemm_run(C, S, EpiBf16{WSP(bf16, O_PP), D, 0, 1.0f}); }
            SEAM(p0 + LP_NORM3);
        }
        if (IN(p0 + LP_PLE)) {
            PHASE_LOCALS;
            PlainSched S{WSP(bf16, O_HN), WSP(bf16, O_WPG + l * SZ_WPG), 2048, 2048, 2048, 32, 8, C.G, C.bid};
            if constexpr (l == 1) gemm_run(C, S, EpiPleT<false>{WSP(bf16, O_H), ka->out, WSP(bf16, O_PP)});
            else gemm_run(C, S, EpiPleT<true>{WSP(bf16, O_H), WSP(bf16, O_H), WSP(bf16, O_PP)});
            SEAM(p0 + LP_PLE);
        }
        if (l == 0 && IN(p0 + LP_NORM1)) {
            PHASE_LOCALS;
            rmsnorm_rows<false, FP8_GATES ? 2 : 0>(C, WSP(bf16, O_H), INF(3) + D, WSP(bf16, O_HN), nullptr, nullptr, nullptr, WSP(unsigned char, O_HN8));
            SEAM(p0 + LP_NORM1);
        }
}

__global__ void __launch_bounds__(512, 2) mk_fwd(Args a) {
    extern __shared__ __attribute__((aligned(16))) unsigned char lds_raw[];
    LAS unsigned char* const lds0 = (LAS unsigned char*)lds_raw;
    volatile LAS unsigned* MISC = (volatile LAS unsigned*)(lds0 + LDS_MISC);
    const int wave_s = __builtin_amdgcn_readfirstlane((int)threadIdx.x >> 6);
    if (threadIdx.x < 16) MISC[threadIdx.x] = 0u;
    __syncthreads();
    const int lo = a.ph_lo, hi = a.ph_hi;
    XcdBarrier bar; bar.bar = (unsigned*)(a.ws) + CW_BAR; bar.x = 0; bar.st = MISC; bar.wave = wave_s;
    const bool multi = (hi - lo) > 1;
    if (multi) bar = xcd_barrier_post((unsigned*)(a.ws) + CW_BAR, MISC, wave_s);

    if (IN(0)) {
        PHASE_LOCALS;
        for (int rp = 0; rp < PB(0); ++rp) {
        for (int l = 0; l < 2; ++l) {
#if FP8_GATES
            conv_job(C, WSP(bf16, O_WIN + l * SZ_WIN), PX_GATE, 2048, 13712, RsWin{INF(4) + (size_t)l * 2048 * 13712});
            conv_job_fp8(C, WSP(unsigned char, O_WIN + l * SZ_WIN + (size_t)PX_GATE * 2048 * 2), 6144, 2048, 13712, RsPlain{INF(4) + (size_t)l * 2048 * 13712 + 7568}, F8_WSCALE);
#else
            conv_job(C, WSP(bf16, O_WIN + l * SZ_WIN), PROJ_N, 2048, 13712, RsWin{INF(4) + (size_t)l * 2048 * 13712});
#endif
            conv_job(C, WSP(bf16, O_WUQ + l * SZ_WUQ), 1536, 768, 1536, RsPlain{INF(16) + (size_t)l * 768 * 1536});
            conv_job(C, WSP(bf16, O_WUKV + l * SZ_WUKV), 2048, 512, 2048, RsPlain{INF(17) + (size_t)l * 512 * 2048});
            for (int n = 0; n < 3; ++n) conv_job(C, WSP(bf16, O_WBR + (l * 3 + n) * SZ_WBR), 2048, 1024, 2048, RsPlain{INF(20) + (size_t)(l * 3 + n) * 1024 * 2048});
            conv_job(C, WSP(bf16, O_WOUT + l * SZ_WOUT), 2048, 2048, 2048, RsPlain{INF(21) + (size_t)l * 2048 * 2048});
            conv_job(C, WSP(bf16, O_WPG + l * SZ_WPG), 2048, 2048, 2048, RsPlain{INF(31) + (size_t)l * 2048 * 2048});
            conv_job(C, WSP(bf16, O_WPP + l * SZ_WPP), 2048, 256, 2048, RsPlain{INF(32) + (size_t)l * 256 * 2048});
            { bf16* dst = WSP(bf16, O_WLRU + l * SZ_WLRU); const float* wa = INF(7) + (size_t)l * 8 * 128 * 128; const float* wx = INF(9) + (size_t)l * 8 * 128 * 128;
              for (int i = C.bid * 512 + C.tid; i < 2048 * 256; i += C.G * 512) { const int n = i >> 8, k = i & 255, pn = n >> 8, r = n & 255, gt = r >> 7, d = r & 127, kb = k >> 7, cc = k & 127;
                  const bool on = (2 * (pn >> 1) + kb) == pn; const float wv = (wa + (gt ? (wx - wa) : (ptrdiff_t)0))[(size_t)(pn * 128 + cc) * 128 + d]; dst[i] = on ? f2bf(wv) : (bf16)0; } }
        }
#if FP8_DENSE
        conv_job_fp8(C, WSP(unsigned char, O_WD1), 2 * DFF, 2048, DFF, RsGU{INF(23), INF(24) - INF(23)}, F8_WSCALE);
        conv_job_fp8(C, WSP(unsigned char, O_WD2), 2048, DFF, 2048, RsPlain{INF(25)}, F8_WSCALE);
#else
        conv_job(C, WSP(bf16, O_WD1), 2 * DFF, 2048, DFF, RsGU{INF(23), INF(24) - INF(23)});
        conv_job(C, WSP(bf16, O_WD2), 2048, DFF, 2048, RsPlain{INF(25)});
#endif
        for (int e = 0; e < ((BG_CONV && FP8_MOE && multi) ? 0 : 8); ++e) {
#if FP8_MOE
            conv_job_fp8(C, WSP(unsigned char, O_WM1 + e * (SZ_WM1 / 2)), 2 * EFF, 2048, EFF, RsGU{INF(27) + (size_t)e * 2048 * EFF, INF(28) - INF(27)}, F8_WSCALE);
            conv_job_fp8(C, WSP(unsigned char, O_WM2 + e * (SZ_WM2 / 2)), 2048, EFF, 2048, RsPlain{INF(29) + (size_t)e * EFF * 2048}, F8_WSCALE);
#else
            conv_job(C, WSP(bf16, O_WM1 + e * SZ_WM1), 2 * EFF, 2048, EFF, RsGU{INF(27) + (size_t)e * 2048 * EFF, INF(28) - INF(27)});
            conv_job(C, WSP(bf16, O_WM2 + e * SZ_WM2), 2048, EFF, 2048, RsPlain{INF(29) + (size_t)e * EFF * 2048});
#endif
        }
        { float* sp8 = (float*)(WSP(int, O_MOEI) + MI_SP8); const float* lam = INF(11); for (int i = C.bid * 512 + C.tid; i < 2048; i += C.G * 512) sp8[i] = 8.0f * log1pf(__expf(-lam[i])); }
        { bf16* pb = WSP(bf16, O_PBF); const float* p = INF(1); for (size_t i = (size_t)C.bid * 512 + C.tid; i < (size_t)2 * M * 256 / 4; i += (size_t)C.G * 512) { const f32x4 v = ((const f32x4*)p)[i]; u32x2 w; w.x = pk2(v[0], v[1]); w.y = pk2(v[2], v[3]); ((u32x2*)pb)[i] = w; } }
        rmsnorm_rows<false, FP8_GATES ? 2 : 0, false>(C, INF(0), INF(3), WSP(bf16, O_HN), nullptr, nullptr, nullptr, WSP(unsigned char, O_HN8));
        }
        SEAM(0);
    }

    layer_body<0>(lo, hi, multi, bar, lds0, wave_s);
    layer_body<1>(lo, hi, multi, bar, lds0, wave_s);
#undef IN
#undef SEAM
#undef INF
}

extern "C" void kernel_launch(void* const* d_in, const int* in_sizes, int n_in, void* d_out, int out_size, void* d_ws, size_t ws_size, hipStream_t stream) {
    static int grid = 0;
    if (grid == 0) {
        if (n_in != 33 || out_size != M * D || ws_size < WS_END) { fprintf(stderr, "kernel_launch: unexpected problem (n_in %d, out %d, ws %zu < %zu)\n", n_in, out_size, ws_size, (size_t)WS_END); grid = -1; return; }
        int dev = 0, cus = 0, per_cu = 0;
        if (hipGetDevice(&dev) != hipSuccess || hipDeviceGetAttribute(&cus, hipDeviceAttributeMultiprocessorCount, dev) != hipSuccess) { grid = -1; return; }
        if (hipFuncSetAttribute((const void*)mk_fwd, hipFuncAttributeMaxDynamicSharedMemorySize, LDS_BYTES) != hipSuccess) { fprintf(stderr, "kernel_launch: hipFuncSetAttribute failed\n"); grid = -1; return; }
        if (hipOccupancyMaxActiveBlocksPerMultiprocessor(&per_cu, (const void*)mk_fwd, 512, LDS_BYTES) != hipSuccess || per_cu < 1) fprintf(stderr, "kernel_launch: occupancy query says %d\n", per_cu);
        (void)hipGetLastError();
        grid = cus;
    }
    if (grid < 0) return;
    (void)hipMemsetAsync(d_ws, 0, CTL_BYTES, stream);
    Args a{};
    for (int i = 0; i < 33; ++i) a.in[i] = d_in[i];
    a.out = (float*)d_out; a.ws = (unsigned char*)d_ws;
#if N_LAUNCH_MODE == 1
    a.ph_lo = 0; a.ph_hi = NPH;
    hipLaunchKernelGGL(mk_fwd, dim3(grid), dim3(512), LDS_BYTES, stream, a);
#else
    for (int ph = 0; ph < NPH; ++ph) { if (!phase_active(ph)) continue; a.ph_lo = ph; a.ph_hi = ph + 1; hipLaunchKernelGGL(mk_fwd, dim3(grid), dim3(512), LDS_BYTES, stream, a); }
#endif
}
```
